# Optimizing an MI355X kernel written in HIP

```python
import math
import jax, jax.numpy as jnp
from jax import lax
import numpy as np

D_MODEL = 1024
BATCH = 32
SEQ = 256
DEPTH = 2
DEC_BATCH = 8
DEC_SEQ = 2048
PAST_LEN = 512

GRID_W = 64
N_MIXERS = 2
N_CONV_LAYERS = (DEPTH + 1) // 2
N_ATTN_LAYERS = DEPTH // 2
HEAD_DIM = 128
N_HEADS = D_MODEL // HEAD_DIM
N_KV_HEADS = 2
QKV_DIM = (N_HEADS + 2 * N_KV_HEADS) * HEAD_DIM
D_FF = 2816
CONV_WIDTH = 3
Q_BLOCK = 128
ROPE_THETA = 10000.0
EPS = 1e-6

kernel_name = "hybrid_diffusion_conv_gqa_step"


def rms_norm(x, g):
    xf = x.astype(jnp.float32)
    y = xf * lax.rsqrt(jnp.mean(xf * xf, axis=-1, keepdims=True) + EPS)
    return (y * g.astype(jnp.float32)).astype(x.dtype)


def dwconv3(x, w):
    xp = jnp.pad(x, ((0, 0), (1, 1), (0, 0)))
    return xp[:, :-2] * w[0] + xp[:, 1:-1] * w[1] + xp[:, 2:] * w[2]


def short_conv_mixer(u, w_in, conv_k, w_out):
    b_gate, c_gate, xp = jnp.split(u @ w_in, 3, axis=-1)
    return (b_gate * dwconv3(c_gate * xp, conv_k)) @ w_out


def conv_ffn(u, w_up, conv_k, w_down):
    h = dwconv3(u @ w_up, conv_k)
    g, up = jnp.split(h, 2, axis=-1)
    return (jax.nn.silu(g) * up) @ w_down


def qkv_heads(u, w_qkv, q_gain, k_gain):
    b, l, _ = u.shape
    qkv = u @ w_qkv
    q = qkv[..., :N_HEADS * HEAD_DIM].reshape(b, l, N_HEADS, HEAD_DIM)
    k = qkv[..., N_HEADS * HEAD_DIM:(N_HEADS + N_KV_HEADS) * HEAD_DIM].reshape(b, l, N_KV_HEADS, HEAD_DIM)
    v = qkv[..., (N_HEADS + N_KV_HEADS) * HEAD_DIM:].reshape(b, l, N_KV_HEADS, HEAD_DIM)
    return rms_norm(q, q_gain), rms_norm(k, k_gain), v


def rope_axis(xh, pos):
    d = xh.shape[-1]
    inv = ROPE_THETA ** (-jnp.arange(0, d, 2, dtype=jnp.float32) / d)
    ang = pos.astype(jnp.float32)[:, None] * inv[None, :]
    cos = jnp.cos(ang)[None, :, None, :]
    sin = jnp.sin(ang)[None, :, None, :]
    x1, x2 = jnp.split(xh.astype(jnp.float32), 2, axis=-1)
    return jnp.concatenate([x1 * cos - x2 * sin, x2 * cos + x1 * sin], axis=-1)


def rope_2d(x, row, col):
    half = HEAD_DIM // 2
    y = jnp.concatenate([rope_axis(x[..., :half], row), rope_axis(x[..., half:], col)], axis=-1)
    return y.astype(x.dtype)


def block_attention(q, k, v):
    b, lq, _, _ = q.shape
    g = N_HEADS // N_KV_HEADS
    nb = lq // Q_BLOCK
    qb = q.reshape(b, nb, Q_BLOCK, N_KV_HEADS, g, HEAD_DIM).transpose(1, 0, 2, 3, 4, 5)
    kf = k.astype(jnp.float32)
    vf = v.astype(jnp.float32)
    scale = HEAD_DIM ** -0.5

    def one_block(qblk):
        s = jnp.einsum('bqkgd,bskd->bkgqs', qblk.astype(jnp.float32), kf) * scale
        p = jax.nn.softmax(s, axis=-1)
        return jnp.einsum('bkgqs,bskd->bqkgd', p, vf).astype(q.dtype)

    o = lax.map(one_block, qb)
    return o.transpose(1, 0, 2, 3, 4, 5).reshape(b, lq, N_HEADS * HEAD_DIM)


def modulate_norm(h, g, shift, scale):
    return rms_norm(h, g) * (1.0 + scale) + shift


def gated_residual(h, y, g, gate):
    return h + gate * rms_norm(y, g)


def setup_inputs(seed: int = 0) -> dict:
    key = jax.random.key(seed)
    ks = jax.random.split(key, 24)

    def nrm(k, shape, scale):
        return jax.random.normal(k, shape, jnp.float32) * scale

    def gain(k, shape):
        return 1.0 + 0.05 * jax.random.normal(k, shape, jnp.float32)

    kv_shape_dec = (DEC_BATCH, N_ATTN_LAYERS, PAST_LEN, N_KV_HEADS, HEAD_DIM)
    return {
        'x_prompt': nrm(ks[0], (BATCH, SEQ, D_MODEL), 1.0),
        'x_sample': nrm(ks[1], (DEC_BATCH, DEC_SEQ, D_MODEL), 1.0),
        'cache_k': nrm(ks[2], kv_shape_dec, 1.0),
        'cache_v': nrm(ks[3], kv_shape_dec, 1.0),
        'c': nrm(ks[4], (DEC_BATCH, D_MODEL), 1.0),
        'c_ctx': nrm(ks[5], (D_MODEL,), 1.0),
        'mod_w': nrm(ks[6], (DEPTH, D_MODEL, 6 * D_MODEL), 0.5 * D_MODEL ** -0.5),
        'mod_b': nrm(ks[7], (DEPTH, 6 * D_MODEL), 0.02),
        'norm_mix_pre': gain(ks[8], (DEPTH, D_MODEL)),
        'norm_mix_post': gain(ks[9], (DEPTH, D_MODEL)),
        'norm_ffn_pre': gain(ks[10], (DEPTH, D_MODEL)),
        'norm_ffn_post': gain(ks[11], (DEPTH, D_MODEL)),
        'conv_w_in': nrm(ks[12], (N_CONV_LAYERS, D_MODEL, 3 * D_MODEL), D_MODEL ** -0.5),
        'conv_k': nrm(ks[13], (N_CONV_LAYERS, CONV_WIDTH, D_MODEL), 0.5),
        'conv_w_out': nrm(ks[14], (N_CONV_LAYERS, D_MODEL, D_MODEL), D_MODEL ** -0.5),
        'attn_w_qkv': nrm(ks[15], (N_ATTN_LAYERS, D_MODEL, QKV_DIM), D_MODEL ** -0.5),
        'attn_q_gain': gain(ks[16], (N_ATTN_LAYERS, HEAD_DIM)),
        'attn_k_gain': gain(ks[17], (N_ATTN_LAYERS, HEAD_DIM)),
        'attn_w_o': nrm(ks[18], (N_ATTN_LAYERS, N_HEADS * HEAD_DIM, D_MODEL), (N_HEADS * HEAD_DIM) ** -0.5),
        'ffn_w_up': nrm(ks[19], (DEPTH, D_MODEL, 2 * D_FF), D_MODEL ** -0.5),
        'ffn_conv': nrm(ks[20], (DEPTH, CONV_WIDTH, 2 * D_FF), 0.5),
        'ffn_w_down': nrm(ks[21], (DEPTH, D_FF, D_MODEL), D_FF ** -0.5),
    }


def reference(x_prompt, x_sample, cache_k, cache_v, c, c_ctx, mod_w, mod_b,
              norm_mix_pre, norm_mix_post, norm_ffn_pre, norm_ffn_post,
              conv_w_in, conv_k, conv_w_out, attn_w_qkv, attn_q_gain, attn_k_gain, attn_w_o,
              ffn_w_up, ffn_conv, ffn_w_down):
    n_lat = x_sample.shape[1]
    rows_n = n_lat // GRID_W
    row = jnp.repeat(jnp.arange(rows_n, dtype=jnp.int32), GRID_W)
    col = jnp.tile(jnp.arange(GRID_W, dtype=jnp.int32), rows_n)

    silu_c = jax.nn.silu(c)
    silu_ctx = jax.nn.silu(c_ctx)

    h_ctx = x_prompt
    h_lat = x_sample
    new_k_list = []
    new_v_list = []
    for i in range(DEPTH):
        j = i // N_MIXERS
        mod_ctx = (silu_ctx @ mod_w[i] + mod_b[i])[None, None, :]
        mod_lat = (silu_c @ mod_w[i] + mod_b[i])[:, None, :]
        s1c, sc1c, g1c, s2c, sc2c, g2c = jnp.split(mod_ctx, 6, axis=-1)
        s1l, sc1l, g1l, s2l, sc2l, g2l = jnp.split(mod_lat, 6, axis=-1)

        u_ctx = modulate_norm(h_ctx, norm_mix_pre[i], s1c, sc1c)
        u_lat = modulate_norm(h_lat, norm_mix_pre[i], s1l, sc1l)
        if i % N_MIXERS == 0:
            y_ctx = short_conv_mixer(u_ctx, conv_w_in[j], conv_k[j], conv_w_out[j])
            y_lat = short_conv_mixer(u_lat, conv_w_in[j], conv_k[j], conv_w_out[j])
        else:
            q_c, k_c, v_c = qkv_heads(u_ctx, attn_w_qkv[j], attn_q_gain[j], attn_k_gain[j])
            y_ctx = block_attention(q_c, k_c, v_c) @ attn_w_o[j]
            new_k_list.append(k_c)
            new_v_list.append(v_c)
            q_l, k_l, v_l = qkv_heads(u_lat, attn_w_qkv[j], attn_q_gain[j], attn_k_gain[j])
            q_l = rope_2d(q_l, row, col)
            k_l = rope_2d(k_l, row, col)
            k_all = jnp.concatenate([cache_k[:, j].astype(k_l.dtype), k_l], axis=1)
            v_all = jnp.concatenate([cache_v[:, j].astype(v_l.dtype), v_l], axis=1)
            y_lat = block_attention(q_l, k_all, v_all) @ attn_w_o[j]
        h_ctx = gated_residual(h_ctx, y_ctx, norm_mix_post[i], g1c)
        h_lat = gated_residual(h_lat, y_lat, norm_mix_post[i], g1l)

        u_ctx = modulate_norm(h_ctx, norm_ffn_pre[i], s2c, sc2c)
        u_lat = modulate_norm(h_lat, norm_ffn_pre[i], s2l, sc2l)
        f_ctx = conv_ffn(u_ctx, ffn_w_up[i], ffn_conv[i], ffn_w_down[i])
        f_lat = conv_ffn(u_lat, ffn_w_up[i], ffn_conv[i], ffn_w_down[i])
        h_ctx = gated_residual(h_ctx, f_ctx, norm_ffn_post[i], g2c)
        h_lat = gated_residual(h_lat, f_lat, norm_ffn_post[i], g2l)

    new_k = jnp.stack(new_k_list, axis=1)
    new_v = jnp.stack(new_v_list, axis=1)
    return (h_ctx, h_lat, new_k, new_v)
```

```cpp
#include <hip/hip_runtime.h>
#include <cstdio>
#include <cstdint>

#ifndef MK_N_LAUNCHES
#define MK_N_LAUNCHES 1
#endif

#define GAS __attribute__((address_space(1)))
#define LAS __attribute__((address_space(3)))
typedef unsigned short bf16_t;
typedef short bf16x8 __attribute__((ext_vector_type(8)));
typedef short s16x4 __attribute__((ext_vector_type(4)));
typedef float f32x4 __attribute__((ext_vector_type(4)));
typedef float f32x2 __attribute__((ext_vector_type(2)));
typedef float f32x16 __attribute__((ext_vector_type(16)));
typedef unsigned u32x4 __attribute__((ext_vector_type(4)));
typedef unsigned u32x2 __attribute__((ext_vector_type(2)));

constexpr int DM = 1024, T_CTX = 8192, T_LAT = 16384, T_ALL = T_CTX + T_LAT, SEQ_C = 256, SEQ_L = 2048, PAST = 512, KV_LAT = PAST + SEQ_L;
constexpr int DFF = 2816, NUP = 2 * DFF, NQKV = 1536, NIN = 3072, NMOD = 6 * DM, HD = 128, NKVH = 2, NQH = 8, KVW = NKVH * HD;
constexpr float EPS = 1e-6f;

constexpr size_t MiB = 1u << 20;
constexpr size_t WS_CTL = 0, CTL_ZERO_BYTES = 64 * 1024;
constexpr size_t WS_MOD = 1 * MiB;
constexpr size_t WS_ROPE = 1 * MiB + 512 * 1024;
constexpr size_t WS_RAWB = 2 * MiB;
constexpr size_t WS_WIN = 8 * MiB, WS_WOUT = 14 * MiB, WS_WQKV = 16 * MiB, WS_WO = 19 * MiB, WS_WUP = 21 * MiB, WS_WDN = 43 * MiB;
constexpr size_t WS_XN = 54 * MiB;
constexpr size_t WS_BIG = 102 * MiB;
constexpr size_t WS_END = 250 * MiB;
constexpr size_t BIG_CV = 0;
constexpr size_t BIG_A2 = 0;
constexpr size_t BIG_QKV = 0, BIG_O = 0;
constexpr size_t BIG_Q = 72 * MiB, BIG_KALL = 120 * MiB, BIG_VALL = 130 * MiB, BIG_KC = 140 * MiB, BIG_VC = 144 * MiB;
constexpr int CW_BAR = 1024;

constexpr int RING_BYTES = 131072, XB_OFF = RING_BYTES, XB_BYTES = 8192, LDSCTL_OFF = XB_OFF + XB_BYTES, MISC_OFF = LDSCTL_OFF + 64, LDS_BYTES = 147456;

__device__ __forceinline__ unsigned f2bf(float f) { unsigned u = __builtin_bit_cast(unsigned, f); return (u + 0x7fffu + ((u >> 16) & 1u)) >> 16; }
__device__ __forceinline__ unsigned pk2(float lo, float hi) { return f2bf(lo) | (f2bf(hi) << 16); }
__device__ __forceinline__ float bflo(unsigned w) { return __builtin_bit_cast(float, w << 16); }
__device__ __forceinline__ float bfhi(unsigned w) { return __builtin_bit_cast(float, w & 0xffff0000u); }
__device__ __forceinline__ unsigned cvt_pk_bf16(float lo, float hi) { unsigned r; asm volatile("v_cvt_pk_bf16_f32 %0, %1, %2" : "=v"(r) : "v"(lo), "v"(hi)); return r; }
__device__ __forceinline__ float wave_sum(float v) {
#pragma unroll
    for (int o = 1; o < 64; o <<= 1) v += __shfl_xor(v, o);
    return v;
}
__device__ __forceinline__ float silu_f(float x) { const float e = __builtin_amdgcn_exp2f(-x * 1.4426950408889634f); return x * __builtin_amdgcn_rcpf(1.0f + e); }
#define LDS_WAIT() asm volatile("s_waitcnt lgkmcnt(0)" ::: "memory")
#define VM_WAIT() asm volatile("s_waitcnt vmcnt(0)" ::: "memory")

namespace pg8 {
constexpr int BM = 256, BK = 64, HALF = 128, HTB = HALF * BK * 2, STAGE_BYTES = 8 * HTB, NXCD = 8, WGM = 8;
__device__ __forceinline__ int lds_byte(int r, int c) { const int st = (r >> 4) * 2 + (c >> 5), rr = r & 15, cc = c & 31, ob = rr * 64 + cc * 2; return st * 1024 + (ob ^ (((ob >> 9) & 1) << 5)); }
__device__ __forceinline__ void stage_rc(int b, int& R, int& C) { const int st = b / 1024, sb = b % 1024, swz = sb ^ (((sb >> 9) & 1) << 5); R = (st >> 1) * 16 + swz / 64; C = (st & 1) * 32 + (swz % 64) / 2; }
__device__ __forceinline__ int perm32(int rho) { const int n = rho >> 4, i = rho & 15; return 8 * (i >> 2) + 4 * n + (i & 3); }

struct Unit { int pm, pn; };
struct Gemm { const bf16_t* A; const bf16_t* Bt; int M, N, K, lda, ldb; };

struct StaticOrder {
    int nM, nN, nwg, G, c;
    __device__ void init(int M, int N, int G_, int c_) { nM = M / BM; nN = N / BM; nwg = nM * nN; G = G_; c = c_; }
    __device__ bool next(int i, Unit& u) const {
        const long L = (long)i * G + c; if (L >= nwg) return false;
        int wgid = (int)L; { const int q = nwg / NXCD, r = nwg % NXCD, xcd = wgid % NXCD, off = wgid / NXCD; wgid = (xcd < r ? xcd * (q + 1) : r * (q + 1) + (xcd - r) * q) + off; }
        const int nig = WGM * nN, gid = wgid / nig, fm = gid * WGM, gsz = (nM - fm) < WGM ? (nM - fm) : WGM;
        u.pm = fm + ((wgid % nig) % gsz); u.pn = (wgid % nig) / gsz; return true;
    }
};

struct EpiBf16 {
    static constexpr bool PERM = true;
    bf16_t* O; int ldc;
    __device__ __forceinline__ void operator()(const f32x4 (&acc)[2][2][4][2], const Unit& u, int wr, int wc, int fr, int fq, LAS unsigned char*, int) const {
        const int row0 = u.pm * BM + wr * 64 + fr; const int col0 = u.pn * BM + wc * 32 + 8 * fq;
#pragma unroll
        for (int ai = 0; ai < 2; ++ai)
#pragma unroll
            for (int m = 0; m < 4; ++m) { bf16_t* rowp = O + (size_t)(row0 + ai * HALF + m * 16) * ldc + col0;
#pragma unroll
                for (int bj = 0; bj < 2; ++bj) { const f32x4 v0 = acc[ai][bj][m][0], v1 = acc[ai][bj][m][1];
                    u32x4 w; w.x = cvt_pk_bf16(v0[0], v0[1]); w.y = cvt_pk_bf16(v0[2], v0[3]); w.z = cvt_pk_bf16(v1[0], v1[1]); w.w = cvt_pk_bf16(v1[2], v1[3]);
                    *(u32x4*)(rowp + bj * HALF) = w; } }
    }
};

__device__ __forceinline__ float dpp_shr1(float x) { return __builtin_bit_cast(float, __builtin_amdgcn_update_dpp(0, __builtin_bit_cast(int, x), 0x111, 0xf, 0xf, true)); }
__device__ __forceinline__ float dpp_shl1(float x) { return __builtin_bit_cast(float, __builtin_amdgcn_update_dpp(0, __builtin_bit_cast(int, x), 0x101, 0xf, 0xf, true)); }
__device__ __forceinline__ float dpp_ror1(float x) { return __builtin_bit_cast(float, __builtin_amdgcn_update_dpp(0, __builtin_bit_cast(int, x), 0x121, 0xf, 0xf, true)); }
__device__ __forceinline__ float dpp_ror15(float x) { return __builtin_bit_cast(float, __builtin_amdgcn_update_dpp(0, __builtin_bit_cast(int, x), 0x12F, 0xf, 0xf, true)); }

struct EpiFfn {
    static constexpr bool PERM = true;
    bf16_t* A2; const float* cw; float* rawb;
    __device__ __forceinline__ void operator()(const f32x4 (&acc)[2][2][4][2], const Unit& u, int wr, int wc, int fr, int fq, LAS unsigned char* xb, int lane) const {
        (void)lane;
        const int ccol = wc * 32 + 8 * fq;
        const int f0 = u.pn * HALF + ccol;
        LAS float* XB = (LAS float*)xb;
        if (fr == 0) {
#pragma unroll
            for (int ai = 0; ai < 2; ++ai)
#pragma unroll
                for (int bj = 0; bj < 2; ++bj)
#pragma unroll
                    for (int n = 0; n < 2; ++n) *(LAS f32x4*)(XB + (ai * 4 + wr * 2 + 0) * 256 + bj * HALF + ccol + 4 * n) = acc[ai][bj][0][n];
        }
        if (fr == 15) {
#pragma unroll
            for (int ai = 0; ai < 2; ++ai)
#pragma unroll
                for (int bj = 0; bj < 2; ++bj)
#pragma unroll
                    for (int n = 0; n < 2; ++n) *(LAS f32x4*)(XB + (ai * 4 + wr * 2 + 1) * 256 + bj * HALF + ccol + 4 * n) = acc[ai][bj][3][n];
        }
        if (u.pm >= 32) {
            const int lt = u.pm - 32;
            if (wr == 0 && fr < 2) {
#pragma unroll
                for (int bj = 0; bj < 2; ++bj)
#pragma unroll
                    for (int n = 0; n < 2; ++n) *(f32x4*)(rawb + (size_t)(lt * 4 + fr) * NUP + bj * DFF + f0 + 4 * n) = acc[0][bj][0][n];
            }
            if (wr == 1 && fr >= 14) {
#pragma unroll
                for (int bj = 0; bj < 2; ++bj)
#pragma unroll
                    for (int n = 0; n < 2; ++n) *(f32x4*)(rawb + (size_t)(lt * 4 + fr - 12) * NUP + bj * DFF + f0 + 4 * n) = acc[1][bj][3][n];
            }
        }
        asm volatile("s_waitcnt lgkmcnt(0)" ::: "memory"); __builtin_amdgcn_s_barrier(); asm volatile("" ::: "memory");
        const float e0 = (fr == 0) ? 1.f : 0.f, e15 = (fr == 15) ? 1.f : 0.f;
#pragma unroll
        for (int n = 0; n < 2; ++n) {
            f32x4 w0[2], w1[2], w2[2];
#pragma unroll
            for (int bj = 0; bj < 2; ++bj) { const float* p = cw + bj * DFF + f0 + 4 * n; w0[bj] = *(const f32x4*)p; w1[bj] = *(const f32x4*)(p + NUP); w2[bj] = *(const f32x4*)(p + 2 * NUP); }
#pragma unroll
            for (int ai = 0; ai < 2; ++ai) {
                f32x4 pe[2], ne[2];
                const bool hasp = !(ai == 0 && wr == 0), hasn = !(ai == 1 && wr == 1);
                const int pslot = (wr == 1) ? (ai * 4 + 0 * 2 + 1) : (0 * 4 + 1 * 2 + 1);
                const int nslot = (wr == 0) ? (ai * 4 + 1 * 2 + 0) : (1 * 4 + 0 * 2 + 0);
#pragma unroll
                for (int bj = 0; bj < 2; ++bj) {
                    pe[bj] = hasp ? *(LAS f32x4*)(XB + pslot * 256 + bj * HALF + ccol + 4 * n) : (f32x4){0.f, 0.f, 0.f, 0.f};
                    ne[bj] = hasn ? *(LAS f32x4*)(XB + nslot * 256 + bj * HALF + ccol + 4 * n) : (f32x4){0.f, 0.f, 0.f, 0.f};
                }
#pragma unroll
                for (int m = 0; m < 4; ++m) {
                    float cv[2][4];
#pragma unroll
                    for (int bj = 0; bj < 2; ++bj)
#pragma unroll
                        for (int j = 0; j < 4; ++j) {
                            const float x = acc[ai][bj][m][n][j];
                            const float xpe = (m > 0) ? dpp_ror1(acc[ai][bj][m > 0 ? m - 1 : 0][n][j]) : pe[bj][j];
                            const float xne = (m < 3) ? dpp_ror15(acc[ai][bj][m < 3 ? m + 1 : 3][n][j]) : ne[bj][j];
                            float c = w1[bj][j] * x;
                            c = fmaf(dpp_shr1(x), w0[bj][j], c);
                            c = fmaf(dpp_shl1(x), w2[bj][j], c);
                            c = fmaf(xpe * e0, w0[bj][j], c);
                            c = fmaf(xne * e15, w2[bj][j], c);
                            cv[bj][j] = c;
                        }
                    float a[4];
#pragma unroll
                    for (int j = 0; j < 4; ++j) a[j] = silu_f(cv[0][j]) * cv[1][j];
                    u32x2 w; w.x = cvt_pk_bf16(a[0], a[1]); w.y = cvt_pk_bf16(a[2], a[3]);
                    const int row = u.pm * BM + ai * HALF + wr * 64 + m * 16 + fr;
                    *(u32x2*)(A2 + (size_t)row * DFF + f0 + 4 * n) = w;
                }
            }
        }
    }
};

template <class Epi, bool ALIGN_EPI = true, bool SP2 = true>
__device__ __forceinline__ void gemm_phase(LAS unsigned char* lds, LAS unsigned char* xb, const Gemm g, const StaticOrder& S, const Epi& E) {
    const int tid = threadIdx.x, wid = __builtin_amdgcn_readfirstlane(tid >> 6), lane = tid & 63, wr = wid >> 2, wc = wid & 3, fr = lane & 15, fq = lane >> 4;
    const int K = g.K, nt = K / BK;
    unsigned voffA[2], voffB[2];
#pragma unroll
    for (int i = 0; i < 2; ++i) { int R, C; stage_rc(tid * 16 + i * 8192, R, C); const int Rb = Epi::PERM ? ((R & ~31) + perm32(R & 31)) : R;
        voffA[i] = (unsigned)(R * g.lda + C) * 2u; voffB[i] = (unsigned)(Rb * g.ldb + C) * 2u; }
    const size_t kstep = (size_t)(BK * 2);
    const size_t hstepA = (size_t)HALF * g.lda * 2, hstepB = (size_t)HALF * g.ldb * 2;
    const size_t tstepA = 2 * hstepA, tstepB = 2 * hstepB;
    const unsigned ldsw = (unsigned)wid * 1024u;
    const int aoff = lds_byte(wr * 64 + fr, fq * 8), boff = lds_byte(wc * 32 + fr, fq * 8);
#define PG8_SA(b, h) (((b) * 2 + (h)) * HTB)
#define PG8_SB(b, h) ((4 + (b) * 2 + (h)) * HTB)
#define PG8_STAGE(bufoff, gbase, voff) do { _Pragma("unroll") for (int _i = 0; _i < 2; ++_i) \
        __builtin_amdgcn_global_load_lds((const unsigned*)((const char*)(gbase) + (voff)[_i]), (LAS unsigned*)(lds + (bufoff) + ldsw + _i * 8192), 16, 0, 0); } while (0)
#define PG8_LDA(dst, b, h) do { _Pragma("unroll") for (int m = 0; m < 4; ++m) _Pragma("unroll") for (int k = 0; k < 2; ++k) dst[m][k] = *(const LAS bf16x8*)(lds + PG8_SA(b, h) + aoff + m * 2048 + k * 1024); } while (0)
#define PG8_LDB(dst, b, h) do { _Pragma("unroll") for (int n = 0; n < 2; ++n) _Pragma("unroll") for (int k = 0; k < 2; ++k) dst[n][k] = *(const LAS bf16x8*)(lds + PG8_SB(b, h) + boff + n * 2048 + k * 1024); } while (0)
#define PG8_MMA(ai, bj, At, Bt) do { __builtin_amdgcn_s_setprio(1); _Pragma("unroll") for (int m = 0; m < 4; ++m) _Pragma("unroll") for (int n = 0; n < 2; ++n) _Pragma("unroll") for (int k = 0; k < 2; ++k) \
        acc[ai][bj][m][n] = __builtin_amdgcn_mfma_f32_16x16x32_bf16(Bt[n][k], At[m][k], acc[ai][bj][m][n], 0, 0, 0); __builtin_amdgcn_s_setprio(0); } while (0)
#define PG8_WAIT_V(n) asm volatile("s_waitcnt vmcnt(" #n ")" ::: "memory")
#define PG8_WAIT_L(n) asm volatile("s_waitcnt lgkmcnt(" #n ")" ::: "memory")
#define PG8_BAR __builtin_amdgcn_s_barrier()
#define PG8_SCHED __builtin_amdgcn_sched_barrier(0)
    Unit cur, nxt; int ui = 0;
    if (!S.next(0, cur)) return;
    f32x4 acc[2][2][4][2];
#pragma unroll
    for (int a = 0; a < 2; ++a)
#pragma unroll
        for (int b = 0; b < 2; ++b)
#pragma unroll
            for (int m = 0; m < 4; ++m)
#pragma unroll
                for (int n = 0; n < 2; ++n) acc[a][b][m][n] = (f32x4){0.f, 0.f, 0.f, 0.f};
    bf16x8 At[4][2], B0[2][2], B1[2][2];
    const char* cA = (const char*)g.A + (size_t)cur.pm * tstepA; const char* cB = (const char*)g.Bt + (size_t)cur.pn * tstepB;
    if constexpr (SP2) {
        PG8_STAGE(PG8_SB(0, 0), cB, voffB); PG8_STAGE(PG8_SB(0, 1), cB + hstepB, voffB); PG8_STAGE(PG8_SA(0, 0), cA, voffA); PG8_STAGE(PG8_SA(0, 1), cA + hstepA, voffA);
        if (wr == 1) PG8_BAR;
        PG8_WAIT_V(2); PG8_BAR;
        PG8_STAGE(PG8_SB(1, 0), cB + kstep, voffB); PG8_STAGE(PG8_SA(1, 0), cA + kstep, voffA); PG8_STAGE(PG8_SB(1, 1), cB + hstepB + kstep, voffB);
        PG8_WAIT_V(6); PG8_BAR;
    } else {
        PG8_STAGE(PG8_SB(0, 0), cB, voffB); PG8_STAGE(PG8_SA(0, 0), cA, voffA); PG8_STAGE(PG8_SB(0, 1), cB + hstepB, voffB); PG8_STAGE(PG8_SA(0, 1), cA + hstepA, voffA);
        if (wr == 1) PG8_BAR;
        PG8_WAIT_V(4); PG8_BAR;
        PG8_STAGE(PG8_SB(1, 0), cB + kstep, voffB); PG8_STAGE(PG8_SA(1, 0), cA + kstep, voffA); PG8_STAGE(PG8_SB(1, 1), cB + hstepB + kstep, voffB);
        PG8_WAIT_V(6); PG8_BAR;
    }
    for (;;) {
        const bool has_next = S.next(ui + 1, nxt);
        const char* nA = has_next ? (const char*)g.A + (size_t)nxt.pm * tstepA : cA; const char* nB = has_next ? (const char*)g.Bt + (size_t)nxt.pn * tstepB : cB;
        for (int t = 0; t < nt; t += 2) {
            const bool last = (t == nt - 2);
            const char* a1 = cA + (size_t)(t + 1) * kstep;
            const char* a2 = last ? nA : cA + (size_t)(t + 2) * kstep; const char* b2 = last ? nB : cB + (size_t)(t + 2) * kstep;
            const char* a3 = a2 + kstep; const char* b3 = b2 + kstep;
            if constexpr (SP2) {
            PG8_LDB(B0, 0, 0); PG8_LDB(B1, 0, 1); PG8_SCHED; PG8_LDA(At, 0, 0); PG8_STAGE(PG8_SA(1, 1), a1 + hstepA, voffA);
            PG8_WAIT_V(8); PG8_WAIT_L(0); PG8_BAR; PG8_MMA(0, 0, At, B0); PG8_MMA(0, 1, At, B1); PG8_BAR; PG8_SCHED;
            PG8_LDA(At, 0, 1); PG8_STAGE(PG8_SB(0, 0), b2, voffB); PG8_STAGE(PG8_SB(0, 1), b2 + hstepB, voffB); PG8_STAGE(PG8_SA(0, 0), a2, voffA);
            PG8_WAIT_V(8); PG8_WAIT_L(0); PG8_BAR; PG8_MMA(1, 0, At, B0); PG8_MMA(1, 1, At, B1); PG8_BAR; PG8_SCHED;
            PG8_LDB(B0, 1, 0); PG8_LDB(B1, 1, 1); PG8_SCHED; PG8_LDA(At, 1, 0); PG8_STAGE(PG8_SA(0, 1), a2 + hstepA, voffA);
            PG8_WAIT_V(8); PG8_WAIT_L(0); PG8_BAR; PG8_MMA(0, 0, At, B0); PG8_MMA(0, 1, At, B1); PG8_BAR; PG8_SCHED;
            PG8_LDA(At, 1, 1); PG8_STAGE(PG8_SB(1, 0), b3, voffB); PG8_STAGE(PG8_SB(1, 1), b3 + hstepB, voffB); PG8_STAGE(PG8_SA(1, 0), a3, voffA);
            PG8_WAIT_V(8); PG8_WAIT_L(0); PG8_BAR; PG8_MMA(1, 0, At, B0); PG8_MMA(1, 1, At, B1); PG8_BAR; PG8_SCHED;
            } else {
            PG8_LDB(B0, 0, 0); PG8_SCHED; PG8_LDA(At, 0, 0); PG8_STAGE(PG8_SA(1, 1), a1 + hstepA, voffA);
            PG8_WAIT_L(8); PG8_BAR; PG8_WAIT_L(0); PG8_MMA(0, 0, At, B0); PG8_BAR; PG8_SCHED;
            PG8_LDB(B1, 0, 1); PG8_STAGE(PG8_SB(0, 0), b2, voffB);
            PG8_BAR; PG8_WAIT_L(0); PG8_MMA(0, 1, At, B1); PG8_BAR;
            PG8_LDA(At, 0, 1); PG8_STAGE(PG8_SA(0, 0), a2, voffA);
            PG8_BAR; PG8_WAIT_L(0); PG8_MMA(1, 0, At, B0); PG8_BAR; PG8_SCHED;
            PG8_STAGE(PG8_SB(0, 1), b2 + hstepB, voffB);
            PG8_WAIT_V(6); PG8_BAR; PG8_MMA(1, 1, At, B1); PG8_BAR;
            PG8_LDB(B0, 1, 0); PG8_SCHED; PG8_LDA(At, 1, 0); PG8_STAGE(PG8_SA(0, 1), a2 + hstepA, voffA);
            PG8_WAIT_L(8); PG8_BAR; PG8_WAIT_L(0); PG8_MMA(0, 0, At, B0); PG8_BAR; PG8_SCHED;
            PG8_LDB(B1, 1, 1); PG8_STAGE(PG8_SB(1, 0), b3, voffB);
            PG8_BAR; PG8_WAIT_L(0); PG8_MMA(0, 1, At, B1); PG8_BAR;
            PG8_LDA(At, 1, 1); PG8_STAGE(PG8_SA(1, 0), a3, voffA);
            PG8_BAR; PG8_WAIT_L(0); PG8_MMA(1, 0, At, B0); PG8_BAR; PG8_SCHED;
            PG8_STAGE(PG8_SB(1, 1), b3 + hstepB, voffB);
            PG8_WAIT_V(6); PG8_BAR; PG8_MMA(1, 1, At, B1); PG8_BAR;
            }
        }
        if constexpr (ALIGN_EPI) { if (wr == 0) PG8_BAR; }
        E(acc, cur, wr, wc, fr, fq, xb, lane);
        if (!has_next) break;
#pragma unroll
        for (int a = 0; a < 2; ++a)
#pragma unroll
            for (int b = 0; b < 2; ++b)
#pragma unroll
                for (int m = 0; m < 4; ++m)
#pragma unroll
                    for (int n = 0; n < 2; ++n) acc[a][b][m][n] = (f32x4){0.f, 0.f, 0.f, 0.f};
        cur = nxt; cA = nA; cB = nB; ++ui;
        if constexpr (ALIGN_EPI) { if (wr == 1) PG8_BAR; }
    }
    PG8_WAIT_V(0);
    if constexpr (!ALIGN_EPI) { if (wr == 0) PG8_BAR; }
    PG8_BAR;
#undef PG8_SA
#undef PG8_SB
#undef PG8_STAGE
#undef PG8_LDA
#undef PG8_LDB
#undef PG8_MMA
#undef PG8_WAIT_V
#undef PG8_WAIT_L
#undef PG8_BAR
#undef PG8_SCHED
}
}

namespace att {
constexpr int D = 128, NW = 8, QBLK = 32, KVBLK = 64;
constexpr float SCALE = 0.088388347648318440f;
constexpr float THR = 8.f;
constexpr int LDQ = DM, LDK = KVW, LDO = DM;
constexpr size_t SHM_V = KVBLK * D * 2, SHM_K = KVBLK * D * 2, SHM_ATTN = 2 * SHM_V + 2 * SHM_K + NW * 64 * 4;
#define KSWZ(row, colB) ((row) * 256 + ((colB) ^ (((row) & 7) << 4)))
#define SBAR() __builtin_amdgcn_sched_barrier(0)
__device__ __forceinline__ int crow(int r, int hi) { return (r & 3) + 8 * (r >> 2) + 4 * hi; }
__device__ __forceinline__ unsigned cvtpk(float lo, float hi) { unsigned r; asm volatile("v_cvt_pk_bf16_f32 %0, %1, %2" : "=v"(r) : "v"(lo), "v"(hi)); return r; }
__device__ __forceinline__ bf16x8 ld8(const bf16_t* p) { return *reinterpret_cast<const bf16x8*>(p); }

__device__ __forceinline__ void partialSM(f32x16& p0, f32x16& p1, float& m_reg, float& mn, float& alpha) {
  constexpr float C = SCALE * 1.4426950408889634f;
  float pmax = p0[0];
#pragma unroll
  for (int r = 1; r < 16; ++r) pmax = fmaxf(pmax, p0[r]);
#pragma unroll
  for (int r = 0; r < 16; ++r) pmax = fmaxf(pmax, p1[r]);
  { auto rr = __builtin_amdgcn_permlane32_swap(__float_as_uint(pmax), __float_as_uint(pmax), false, false);
    pmax = fmaxf(__uint_as_float(rr[0]), __uint_as_float(rr[1])); }
  if (__builtin_expect(__all(pmax - m_reg <= THR / SCALE), 1)) { mn = m_reg; alpha = 1.f; }
  else { mn = fmaxf(m_reg, pmax); alpha = __builtin_amdgcn_exp2f((m_reg - mn) * C); m_reg = mn; }
  float mnC = -mn * C;
#pragma unroll
  for (int r = 0; r < 16; ++r) p0[r] = fmaf(p0[r], C, mnC);
#pragma unroll
  for (int r = 0; r < 16; ++r) p1[r] = fmaf(p1[r], C, mnC);
#pragma unroll
  for (int r = 0; r < 16; ++r) p0[r] = __builtin_amdgcn_exp2f(p0[r]);
}
__device__ __forceinline__ void finishSM(f32x16& p0, f32x16& p1, float alpha, float& l_reg, bf16x8& pa0, bf16x8& pa1, bf16x8& pa2, bf16x8& pa3) {
#pragma unroll
  for (int r = 0; r < 16; ++r) p1[r] = __builtin_amdgcn_exp2f(p1[r]);
  float ps = 0;
#pragma unroll
  for (int r = 0; r < 16; ++r) ps += p0[r];
#pragma unroll
  for (int r = 0; r < 16; ++r) ps += p1[r];
  { auto rr = __builtin_amdgcn_permlane32_swap(__float_as_uint(ps), __float_as_uint(ps), false, false);
    ps = __uint_as_float(rr[0]) + __uint_as_float(rr[1]); }
  l_reg = l_reg * alpha + ps;
#define PK4(P, BASE, OUT) do { unsigned a0 = cvtpk(P[BASE + 0], P[BASE + 1]), a1 = cvtpk(P[BASE + 2], P[BASE + 3]);   \
    unsigned b0 = cvtpk(P[BASE + 4], P[BASE + 5]), b1 = cvtpk(P[BASE + 6], P[BASE + 7]);                              \
    auto r0 = __builtin_amdgcn_permlane32_swap(a0, b0, false, false); auto r1 = __builtin_amdgcn_permlane32_swap(a1, b1, false, false); \
    u32x4 w = {r0[0], r1[0], r0[1], r1[1]}; OUT = *reinterpret_cast<bf16x8*>(&w); } while (0)
  PK4(p0, 0, pa0); PK4(p0, 8, pa1); PK4(p1, 0, pa2); PK4(p1, 8, pa3);
#undef PK4
}
__device__ __forceinline__ void qkt(f32x16& p0, f32x16& p1, const bf16_t* Ks, const bf16x8* qr, int r32, int hi) {
  p0 = f32x16{}; p1 = f32x16{};
#pragma unroll
  for (int d0 = 0; d0 < 8; ++d0) { int cb = (d0 * 16 + hi * 8) * 2;
    bf16x8 b0 = *reinterpret_cast<const bf16x8*>((const char*)Ks + KSWZ(r32, cb));
    bf16x8 b1 = *reinterpret_cast<const bf16x8*>((const char*)Ks + KSWZ(32 + r32, cb));
    p0 = __builtin_amdgcn_mfma_f32_32x32x16_bf16(b0, qr[d0], p0, 0, 0, 0);
    p1 = __builtin_amdgcn_mfma_f32_32x32x16_bf16(b1, qr[d0], p1, 0, 0, 0); }
}
__device__ __forceinline__ int v_st(int k, int c) { const int kk = (k & ~0xC) | ((k & 4) << 1) | ((k & 8) >> 1); return ((kk >> 3) * 4 + (c >> 5)) * 512 + ((kk & 7) * 32 + (c & 31)) * 2; }
__device__ __forceinline__ int v_rd_base(int lane) { return ((lane & 3) << 3) | (((lane >> 2) & 3) << 6) | (((lane >> 4) & 1) << 5) | (((lane >> 5) & 1) << 8); }
constexpr int v_rd_off(int d0, int ks, int half) { return d0 * 512 + ks * 4096 + half * 2048; }
template <int OFF> __device__ __forceinline__ s16x4 tr_read(int vb) {
  s16x4 r; asm volatile("ds_read_b64_tr_b16 %0, %1 offset:%2" : "=&v"(r) : "v"(vb), "i"(OFF) : "memory"); return r;
}
template <int D0> __device__ __forceinline__ void pv_one(f32x16& od, int vb, bf16x8 pa0, bf16x8 pa1, bf16x8 pa2, bf16x8 pa3) {
  const s16x4 l0 = tr_read<v_rd_off(D0, 0, 0)>(vb), h0 = tr_read<v_rd_off(D0, 0, 1)>(vb), l1 = tr_read<v_rd_off(D0, 1, 0)>(vb), h1 = tr_read<v_rd_off(D0, 1, 1)>(vb);
  const s16x4 l2 = tr_read<v_rd_off(D0, 2, 0)>(vb), h2 = tr_read<v_rd_off(D0, 2, 1)>(vb), l3 = tr_read<v_rd_off(D0, 3, 0)>(vb), h3 = tr_read<v_rd_off(D0, 3, 1)>(vb);
  asm volatile("s_waitcnt lgkmcnt(0)" ::: "memory"); SBAR();
#define PK(L, H) (bf16x8){L[0], L[1], L[2], L[3], H[0], H[1], H[2], H[3]}
  od = __builtin_amdgcn_mfma_f32_32x32x16_bf16(pa0, PK(l0, h0), od, 0, 0, 0);
  od = __builtin_amdgcn_mfma_f32_32x32x16_bf16(pa1, PK(l1, h1), od, 0, 0, 0);
  od = __builtin_amdgcn_mfma_f32_32x32x16_bf16(pa2, PK(l2, h2), od, 0, 0, 0);
  od = __builtin_amdgcn_mfma_f32_32x32x16_bf16(pa3, PK(l3, h3), od, 0, 0, 0);
#undef PK
}
__device__ __forceinline__ void pv_d0(f32x16* o, int vb, bf16x8 pa0, bf16x8 pa1, bf16x8 pa2, bf16x8 pa3) {
  pv_one<0>(o[0], vb, pa0, pa1, pa2, pa3); pv_one<1>(o[1], vb, pa0, pa1, pa2, pa3); pv_one<2>(o[2], vb, pa0, pa1, pa2, pa3); pv_one<3>(o[3], vb, pa0, pa1, pa2, pa3);
}

__device__ __forceinline__ void attn_dense_body(const bf16_t* __restrict__ Qb, const bf16_t* __restrict__ Kh, const bf16_t* __restrict__ Vh,
                                                bf16_t* __restrict__ Ob, int seq, char* lds) {
  const int tid = threadIdx.x, wid = tid >> 6, lane = tid & 63, r32 = lane & 31, hi = lane >> 5;
  bf16_t* V_lds = (bf16_t*)lds; bf16_t* K_lds = (bf16_t*)(lds + 2 * SHM_V);
  float* ws = (float*)(lds + 2 * SHM_V + 2 * SHM_K) + wid * 64; float* li_l = ws; float* al_l = ws + 32;
  float m_reg = -1e30f, l_reg = 0; f32x16 o[4] = {}; bf16x8 qr[8];
  const bf16_t* Qw = Qb + (long)(wid * QBLK + r32) * LDQ + hi * 8;
#pragma unroll
  for (int d0 = 0; d0 < 8; ++d0) qr[d0] = ld8(Qw + d0 * 16);
  const int sr = tid >> 4, sc = (tid & 15) * 8, vst0 = v_st(sr, sc), vst1 = v_st(32 + sr, sc);
  const int vb0 = (int)(uintptr_t)V_lds + v_rd_base(lane);
  struct { bf16x8 vs0, vs1, ks0, ks1; } sr_[2];
#define SLOAD(i, k0) do { sr_[i].vs0 = ld8(&Vh[(long)((k0) + sr) * LDK + sc]); sr_[i].vs1 = ld8(&Vh[(long)((k0) + 32 + sr) * LDK + sc]); \
    sr_[i].ks0 = ld8(&Kh[(long)((k0) + sr) * LDK + sc]); sr_[i].ks1 = ld8(&Kh[(long)((k0) + 32 + sr) * LDK + sc]); } while (0)
#define SWRITE(b, i) do { *(bf16x8*)((char*)V_lds + (b) * SHM_V + vst0) = sr_[i].vs0;          \
    *(bf16x8*)((char*)V_lds + (b) * SHM_V + vst1) = sr_[i].vs1; int kc = sc * 2;               \
    *(bf16x8*)((char*)K_lds + (b) * SHM_K + KSWZ(sr, kc)) = sr_[i].ks0;                       \
    *(bf16x8*)((char*)K_lds + (b) * SHM_K + KSWZ(32 + sr, kc)) = sr_[i].ks1; } while (0)
#define SWAIT() asm volatile("s_waitcnt vmcnt(4)" ::: "memory")
#define RESC(a) do { if (__any((a) < 1.f)) { if (hi == 0) al_l[r32] = (a); asm volatile("s_waitcnt lgkmcnt(0)" ::: "memory"); \
    _Pragma("unroll") for (int d = 0; d < 4; ++d) _Pragma("unroll") for (int r = 0; r < 16; ++r) o[d][r] *= al_l[crow(r, hi)]; } } while (0)
  f32x16 pA0, pA1, pB0, pB1; float mnA, mnB, alA, alB; bf16x8 pa0, pa1, pa2, pa3; const int NT = seq / KVBLK;
  constexpr int SE = 0, SO = 1;
  SLOAD(SE, 0); asm volatile("s_waitcnt vmcnt(0)" ::: "memory"); SWRITE(0, SE); __syncthreads();
  qkt(pA0, pA1, K_lds, qr, r32, hi); partialSM(pA0, pA1, m_reg, mnA, alA);
  SLOAD(SO, KVBLK); if (2 < NT) SLOAD(SE, 2 * KVBLK);
  SWAIT(); SWRITE(1, SO); __syncthreads();
  for (int j = 1; j + 1 < NT; j += 2) {
    SBAR(); qkt(pB0, pB1, (bf16_t*)((char*)K_lds + SHM_K), qr, r32, hi);
    finishSM(pA0, pA1, alA, l_reg, pa0, pa1, pa2, pa3); SBAR();
    SLOAD(SO, (j + 2) * KVBLK); SBAR();
    pv_d0(o, vb0, pa0, pa1, pa2, pa3); partialSM(pB0, pB1, m_reg, mnB, alB);
    __syncthreads(); SWAIT(); SWRITE(0, SE);
    RESC(alB); __syncthreads();
    SBAR(); qkt(pA0, pA1, K_lds, qr, r32, hi);
    finishSM(pB0, pB1, alB, l_reg, pa0, pa1, pa2, pa3); SBAR();
    if (j + 3 < NT) SLOAD(SE, (j + 3) * KVBLK); SBAR();
    pv_d0(o, vb0 + (int)SHM_V, pa0, pa1, pa2, pa3); partialSM(pA0, pA1, m_reg, mnA, alA);
    __syncthreads(); SWAIT(); SWRITE(1, SO);
    RESC(alA); __syncthreads();
  }
  SBAR(); qkt(pB0, pB1, (bf16_t*)((char*)K_lds + SHM_K), qr, r32, hi);
  finishSM(pA0, pA1, alA, l_reg, pa0, pa1, pa2, pa3); SBAR();
  pv_d0(o, vb0, pa0, pa1, pa2, pa3); partialSM(pB0, pB1, m_reg, mnB, alB);
  __syncthreads(); RESC(alB);
  finishSM(pB0, pB1, alB, l_reg, pa0, pa1, pa2, pa3); SBAR();
  pv_d0(o, vb0 + (int)SHM_V, pa0, pa1, pa2, pa3);
  if (hi == 0) li_l[r32] = l_reg; asm volatile("s_waitcnt lgkmcnt(0)" ::: "memory");
  float rli[16];
#pragma unroll
  for (int r = 0; r < 16; ++r) rli[r] = __builtin_amdgcn_rcpf(li_l[crow(r, hi)]);
  bf16_t* Ow = Ob + (long)(wid * QBLK) * LDO;
#pragma unroll
  for (int r = 0; r < 16; ++r) { int orow = crow(r, hi);
#pragma unroll
    for (int d0 = 0; d0 < 4; ++d0) Ow[(long)orow * LDO + d0 * 32 + r32] = (bf16_t)f2bf(o[d0][r] * rli[r]); }
#undef SLOAD
#undef SWRITE
#undef SWAIT
#undef RESC
}
#undef KSWZ
#undef SBAR
}

#define XB_TMO      128
#define XB_XCNT(j)  (256  + 64 * (j))
#define XB_XSUB(j)  (1280 + 64 * (j))
#define XB_XGEN(j)  (2304 + 64 * (j))
#define XB_TOP      3328
#define XB_TOPGEN   3392
#define XCD_BAR_WORDS 3456
#define XB_SPIN_CAP (1u << 18)
__device__ __forceinline__ unsigned xb_ld(unsigned* p)              { return __hip_atomic_load(p, __ATOMIC_RELAXED, __HIP_MEMORY_SCOPE_AGENT); }
__device__ __forceinline__ unsigned xb_add(unsigned* p, unsigned v) { return __hip_atomic_fetch_add(p, v, __ATOMIC_RELAXED, __HIP_MEMORY_SCOPE_AGENT); }
__device__ __forceinline__ unsigned xb_xcc_id() { return (unsigned)__builtin_amdgcn_s_getreg((3 << 11) | 20) & 0xFu; }
#define XB_SPIN(cond, bar) do { unsigned _sp = 0; while (cond) { __builtin_amdgcn_s_sleep(1); \
    if ((++_sp & 255u) == 0u) { if (xb_ld(&(bar)[XB_TMO])) break; if (_sp > XB_SPIN_CAP) { atomicAdd(&(bar)[XB_TMO], 1u); break; } } } } while (0)
struct XcdBarrier { unsigned* bar; unsigned x; volatile LAS unsigned* st; };
__device__ __forceinline__ XcdBarrier xcd_barrier_post(unsigned* bar, volatile LAS unsigned* st) {
    XcdBarrier b; b.bar = bar; b.x = xb_xcc_id(); b.st = st;
    if (threadIdx.x == 0) (void)xb_add(&bar[XB_XCNT(b.x)], 1u);
    return b;
}
__device__ __forceinline__ void xcd_barrier_complete(unsigned* bar, unsigned x, unsigned& nloc, unsigned& nx) {
    const unsigned G = gridDim.x * gridDim.y * gridDim.z;
    unsigned sum, cnt, mine, sp = 0u;
    for (;;) {
        sum = 0u; cnt = 0u; mine = 0u;
#pragma unroll
        for (unsigned j = 0; j < 16; ++j) { const unsigned c = xb_ld(&bar[XB_XCNT(j)]); sum += c; cnt += (c > 0u) ? 1u : 0u; mine = (j == x) ? c : mine; }
        if (sum == G) break;
        __builtin_amdgcn_s_sleep(1);
        if ((++sp & 255u) == 0u) { if (xb_ld(&bar[XB_TMO])) break; if (sp > XB_SPIN_CAP) { atomicAdd(&bar[XB_TMO], 1u); break; } }
    }
    nloc = mine > 0u ? mine : 1u; nx = cnt > 0u ? cnt : 1u;
}
__device__ __forceinline__ void xcd_barrier(const XcdBarrier& b) {
    asm volatile("s_waitcnt vmcnt(0)" ::: "memory");
    __syncthreads();
    if (threadIdx.x == 0) {
        unsigned* bar = b.bar;
        __builtin_amdgcn_s_waitcnt(0);
        unsigned nloc = b.st[0], nx = b.st[1];
        if (nloc == 0u) { xcd_barrier_complete(bar, b.x, nloc, nx); b.st[0] = nloc; b.st[1] = nx; }
        const unsigned old = xb_add(&bar[XB_XSUB(b.x)], 1u);
        const unsigned gen = old / nloc;
        if (old + 1u == (gen + 1u) * nloc) {
            __builtin_amdgcn_fence(__ATOMIC_RELEASE, "agent");
            asm volatile("s_waitcnt vmcnt(0)" ::: "memory");
            const unsigned og = xb_add(&bar[XB_TOP], 1u);
            const unsigned tg = og / nx;
            if (og + 1u == (tg + 1u) * nx) xb_add(&bar[XB_TOPGEN], 1u);
            else XB_SPIN(xb_ld(&bar[XB_TOPGEN]) == tg, bar);
            __builtin_amdgcn_fence(__ATOMIC_ACQUIRE, "agent");
            xb_add(&bar[XB_XGEN(b.x)], 1u);
            asm volatile("s_waitcnt vmcnt(0)" ::: "memory");
        } else {
            XB_SPIN(xb_ld(&bar[XB_XGEN(b.x)]) == gen, bar);
            __builtin_amdgcn_fence(__ATOMIC_ACQUIRE, "agent");
            asm volatile("s_waitcnt vmcnt(0)" ::: "memory");
        }
    }
    __syncthreads();
}

struct Args {
    const float* in[22]; float* out; unsigned char* ws; int ph_lo, ph_hi;
};
struct Frame {
    LAS unsigned char* lds; unsigned char* ws;
    int tid, lane, wave, vcu, G;
};

__device__ __forceinline__ void transpose_item(const float* W, int K, int N, bf16_t* WT, int ldk, int dest_row0, int k0, int n0, LAS float* scr, int lane) {
#pragma unroll 8
    for (int i = 0; i < 32; ++i) { const int kk = 2 * i + (lane >> 5); scr[kk * 33 + (lane & 31)] = W[(size_t)(k0 + kk) * N + n0 + (lane & 31)]; }
    LDS_WAIT(); asm volatile("" ::: "memory");
    const int c = lane & 7;
#pragma unroll
    for (int j = 0; j < 4; ++j) { const int n = (lane >> 3) + 8 * j; const LAS float* s = scr + (8 * c) * 33 + n;
        u32x4 o; o.x = pk2(s[0 * 33], s[1 * 33]); o.y = pk2(s[2 * 33], s[3 * 33]); o.z = pk2(s[4 * 33], s[5 * 33]); o.w = pk2(s[6 * 33], s[7 * 33]);
        *(u32x4*)(WT + (size_t)(dest_row0 + n) * ldk + k0 + 8 * c) = o; }
    LDS_WAIT(); asm volatile("" ::: "memory");
    (void)K;
}

__device__ __forceinline__ void load16(const float* p, int lane, float (&v)[16]) {
    const f32x4 a = *(const f32x4*)(p + 8 * lane), b = *(const f32x4*)(p + 8 * lane + 4), c = *(const f32x4*)(p + 512 + 8 * lane), d = *(const f32x4*)(p + 512 + 8 * lane + 4);
#pragma unroll
    for (int j = 0; j < 4; ++j) { v[j] = a[j]; v[4 + j] = b[j]; v[8 + j] = c[j]; v[12 + j] = d[j]; }
}
__device__ __forceinline__ void store16f(float* p, int lane, const float (&v)[16]) {
    *(f32x4*)(p + 8 * lane) = (f32x4){v[0], v[1], v[2], v[3]}; *(f32x4*)(p + 8 * lane + 4) = (f32x4){v[4], v[5], v[6], v[7]};
    *(f32x4*)(p + 512 + 8 * lane) = (f32x4){v[8], v[9], v[10], v[11]}; *(f32x4*)(p + 512 + 8 * lane + 4) = (f32x4){v[12], v[13], v[14], v[15]};
}
__device__ __forceinline__ void load16bf(const bf16_t* p, int lane, float (&v)[16]) {
    const u32x4 a = *(const u32x4*)(p + 8 * lane), b = *(const u32x4*)(p + 512 + 8 * lane);
#pragma unroll
    for (int j = 0; j < 4; ++j) { v[2 * j] = bflo(a[j]); v[2 * j + 1] = bfhi(a[j]); v[8 + 2 * j] = bflo(b[j]); v[8 + 2 * j + 1] = bfhi(b[j]); }
}
__device__ __forceinline__ void store16bf(bf16_t* p, int lane, const float (&v)[16]) {
    u32x4 a, b;
#pragma unroll
    for (int j = 0; j < 4; ++j) { a[j] = pk2(v[2 * j], v[2 * j + 1]); b[j] = pk2(v[8 + 2 * j], v[8 + 2 * j + 1]); }
    *(u32x4*)(p + 8 * lane) = a; *(u32x4*)(p + 512 + 8 * lane) = b;
}
__device__ __forceinline__ float sumsq16(const float (&v)[16]) { float s = 0.f;
#pragma unroll
    for (int j = 0; j < 16; ++j) s = fmaf(v[j], v[j], s);
    return s; }

template <int MODE>
__device__ __forceinline__ void row_pass(const Frame& F, const float* hin_ctx, const float* hin_lat, float* hout, const bf16_t* Y, bf16_t* XN,
                                         const float* gpost, const float* gate_mod, const float* gpre, const float* shift_mod, const float* scale_mod) {
    const int gw = F.vcu * 8 + F.wave, lane = F.lane;
    constexpr int RPW = 12;
    float pg[16], gt[16], ng[16], sc[16], sh[16];
    if (MODE != 0) load16(gpost, lane, pg);
    if (MODE != 2) load16(gpre, lane, ng);
    int curb = -1;
    for (int ch = gw; ch < T_ALL / RPW; ch += F.G * 8)
    for (int r = ch * RPW; r < ch * RPW + RPW; ++r) {
        const int b = (r < T_CTX) ? 8 : (r - T_CTX) / SEQ_L;
        if (b != curb) { curb = b;
            if (MODE != 0) load16(gate_mod + (size_t)b * NMOD, lane, gt);
            if (MODE != 2) { load16(scale_mod + (size_t)b * NMOD, lane, sc); load16(shift_mod + (size_t)b * NMOD, lane, sh);
#pragma unroll
                for (int j = 0; j < 16; ++j) sc[j] = (1.0f + sc[j]) * ng[j]; } }
        const float* hp = (r < T_CTX) ? hin_ctx + (size_t)r * DM : hin_lat + (size_t)(r - T_CTX) * DM;
        float h[16]; load16(hp, lane, h);
        if (MODE != 0) {
            float y[16]; load16bf(Y + (size_t)r * DM, lane, y);
            const float rs = __builtin_amdgcn_rsqf(wave_sum(sumsq16(y)) * (1.0f / DM) + EPS);
#pragma unroll
            for (int j = 0; j < 16; ++j) h[j] = fmaf(gt[j], y[j] * rs * pg[j], h[j]);
            store16f(hout + (size_t)r * DM, lane, h);
        }
        if (MODE != 2) {
            const float rs = __builtin_amdgcn_rsqf(wave_sum(sumsq16(h)) * (1.0f / DM) + EPS);
            float x[16];
#pragma unroll
            for (int j = 0; j < 16; ++j) x[j] = fmaf(h[j] * rs, sc[j], sh[j]);
            store16bf(XN + (size_t)r * DM, lane, x);
        }
    }
}

__device__ __forceinline__ void sincos_d(double x, double& s, double& c) {
    const double k = __builtin_rint(x * 0.63661977236758134308);
    const double r = fma(-k, 6.123233995736766036e-17, fma(-k, 1.57079632679489655800, x));
    const double r2 = r * r;
    double sp = -7.647163731819816476e-13; sp = fma(sp, r2, 1.605904383682161460e-10); sp = fma(sp, r2, -2.505210838544171878e-08); sp = fma(sp, r2, 2.755731922398589065e-06);
    sp = fma(sp, r2, -1.984126984126984127e-04); sp = fma(sp, r2, 8.333333333333333333e-03); sp = fma(sp, r2, -1.666666666666666667e-01); sp = fma(sp * r2, r, r);
    double cp = 4.779477332387385297e-14; cp = fma(cp, r2, -1.147074559772972471e-11); cp = fma(cp, r2, 2.087675698786809898e-09); cp = fma(cp, r2, -2.755731922398589065e-07);
    cp = fma(cp, r2, 2.480158730158730159e-05); cp = fma(cp, r2, -1.388888888888888889e-03); cp = fma(cp, r2, 4.166666666666666667e-02); cp = fma(cp, r2, -0.5); cp = fma(cp, r2, 1.0);
    const int q = ((int)k) & 3;
    s = (q == 0) ? sp : (q == 1) ? cp : (q == 2) ? -sp : -cp;
    c = (q == 0) ? cp : (q == 1) ? -sp : (q == 2) ? -cp : sp;
}

constexpr int N_PHASES = 19;

__global__ void __launch_bounds__(512, 2) mega_fwd(Args args) {
    extern __shared__ __attribute__((aligned(16))) unsigned char lds_raw[];
    Frame F;
    F.lds = (LAS unsigned char*)lds_raw; F.ws = args.ws;
    F.tid = threadIdx.x; F.lane = F.tid & 63; F.wave = __builtin_amdgcn_readfirstlane(F.tid >> 6);
    F.G = gridDim.x; { const int bx = blockIdx.x; F.vcu = (F.G % 8 == 0) ? (bx % 8) * (F.G / 8) + bx / 8 : bx; }
    unsigned char* ws = args.ws;
    unsigned* ctl = (unsigned*)(ws + WS_CTL);
    volatile LAS unsigned* MISC = (volatile LAS unsigned*)(F.lds + MISC_OFF);
    for (int u = F.tid; u < (LDS_BYTES - LDSCTL_OFF) / 4; u += 512) ((LAS unsigned*)(F.lds + LDSCTL_OFF))[u] = 0u;
    __syncthreads();
    XcdBarrier bar; bar.bar = ctl + CW_BAR; bar.x = 0; bar.st = nullptr;
    const int lo = args.ph_lo, hi = args.ph_hi;
    if (hi - lo > 1) bar = xcd_barrier_post(ctl + CW_BAR, MISC + 8);
#ifndef PH_MASK
#define PH_MASK 0x7ffff
#endif
#define IN(k) (((PH_MASK >> (k)) & 1) && lo <= (k) && (k) < hi)
#define SEAM(k) do { if (IN(k) && IN((k) + 1)) xcd_barrier(bar); } while (0)

    const float* x_prompt = args.in[0]; const float* x_sample = args.in[1]; const float* cache_k = args.in[2]; const float* cache_v = args.in[3];
    const float* cvec = args.in[4]; const float* c_ctx = args.in[5]; const float* mod_w = args.in[6]; const float* mod_b = args.in[7];
    const float* norm_mix_pre = args.in[8]; const float* norm_mix_post = args.in[9]; const float* norm_ffn_pre = args.in[10]; const float* norm_ffn_post = args.in[11];
    const float* conv_w_in = args.in[12]; const float* conv_k = args.in[13]; const float* conv_w_out = args.in[14]; const float* attn_w_qkv = args.in[15];
    const float* q_gain = args.in[16]; const float* k_gain = args.in[17]; const float* attn_w_o = args.in[18]; const float* ffn_w_up = args.in[19];
    const float* ffn_conv = args.in[20]; const float* ffn_w_down = args.in[21];
    float* H = args.out;
    float* new_k = args.out + (size_t)T_ALL * DM; float* new_v = new_k + (size_t)T_CTX * KVW;
    float* MOD = (float*)(ws + WS_MOD); float* ROPE = (float*)(ws + WS_ROPE); float* RAWB = (float*)(ws + WS_RAWB);
    bf16_t* Win_t = (bf16_t*)(ws + WS_WIN); bf16_t* Wout_t = (bf16_t*)(ws + WS_WOUT); bf16_t* Wqkv_t = (bf16_t*)(ws + WS_WQKV); bf16_t* Wo_t = (bf16_t*)(ws + WS_WO);
    bf16_t* Wup_t = (bf16_t*)(ws + WS_WUP); bf16_t* Wdn_t = (bf16_t*)(ws + WS_WDN);
    bf16_t* XN = (bf16_t*)(ws + WS_XN);
    unsigned char* big = ws + WS_BIG;
    bf16_t* CV = (bf16_t*)(big + BIG_CV); bf16_t* A2 = (bf16_t*)(big + BIG_A2); bf16_t* QKV = (bf16_t*)(big + BIG_QKV); bf16_t* OB = (bf16_t*)(big + BIG_O);
    bf16_t* QB = (bf16_t*)(big + BIG_Q); bf16_t* KALL = (bf16_t*)(big + BIG_KALL); bf16_t* VALL = (bf16_t*)(big + BIG_VALL); bf16_t* KC = (bf16_t*)(big + BIG_KC); bf16_t* VC = (bf16_t*)(big + BIG_VC);
    LAS unsigned char* ring = F.lds; LAS unsigned char* xbuf = F.lds + XB_OFF;
    const int gw = F.vcu * 8 + F.wave, NGW = F.G * 8;

    if (IN(0)) {
        {
            LAS float* sl = (LAS float*)ring;
            LAS float* red = (LAS float*)(ring + 40960);
            for (int it = F.vcu; it < 2 * (NMOD / 64); it += F.G) {
                __syncthreads();
                for (int e = F.tid; e < 9 * DM; e += 512) { const int r = e >> 10, k = e & 1023; const float v = (r < 8) ? cvec[r * DM + k] : c_ctx[k]; sl[e] = silu_f(v); }
                __syncthreads();
                const int layer = it / (NMOD / 64), n0 = (it % (NMOD / 64)) * 64;
                const float* wp = mod_w + (size_t)layer * DM * NMOD + n0 + F.lane;
                float a[9];
#pragma unroll
                for (int r = 0; r < 9; ++r) a[r] = 0.f;
                const int kb = F.wave * 128;
#pragma unroll 4
                for (int k = kb; k < kb + 128; ++k) { const float w = wp[(size_t)k * NMOD];
#pragma unroll
                    for (int r = 0; r < 9; ++r) a[r] = fmaf(sl[r * DM + k], w, a[r]); }
#pragma unroll
                for (int r = 0; r < 9; ++r) red[(F.wave * 9 + r) * 64 + F.lane] = a[r];
                __syncthreads();
                for (int e = F.tid; e < 9 * 64; e += 512) { const int r = e >> 6, l = e & 63; float s = mod_b[layer * NMOD + n0 + l];
#pragma unroll
                    for (int w = 0; w < 8; ++w) s += red[(w * 9 + r) * 64 + l];
                    MOD[((size_t)layer * 9 + r) * NMOD + n0 + l] = s; }
            }
            __syncthreads();
        }
        if (F.vcu == F.G - 1) {
            for (int e = F.tid; e < 64 * 32; e += 512) { const int pos = e >> 5, i = e & 31;
                double inv = 1.0; for (int q = 0; q < i; ++q) inv *= 0.74989420933245582730;
                double s, c; sincos_d((double)pos * inv, s, c);
                ROPE[2 * e] = (float)c; ROPE[2 * e + 1] = (float)s; }
        }
        {
            LAS float* scr = (LAS float*)(ring + F.wave * 16384);
            constexpr int I_IN = 16 * (NIN / 32), I_OUT = 16 * (DM / 32), I_QKV = 16 * (NQKV / 32), I_O = 16 * (DM / 32), I_UP = 16 * (NUP / 32), I_DN = (DFF / 64) * (DM / 32);
            constexpr int NITEMS = I_IN + I_OUT + I_QKV + I_O + 2 * I_UP + 2 * I_DN;
            for (int it = gw; it < NITEMS; it += NGW) {
                int r = it;
                if (r < I_IN) { const int nb = NIN / 32; transpose_item(conv_w_in, DM, NIN, Win_t, DM, (r % nb) * 32, (r / nb) * 64, (r % nb) * 32, scr, F.lane); continue; } r -= I_IN;
                if (r < I_OUT) { const int nb = DM / 32; transpose_item(conv_w_out, DM, DM, Wout_t, DM, (r % nb) * 32, (r / nb) * 64, (r % nb) * 32, scr, F.lane); continue; } r -= I_OUT;
                if (r < I_QKV) { const int nb = NQKV / 32; transpose_item(attn_w_qkv, DM, NQKV, Wqkv_t, DM, (r % nb) * 32, (r / nb) * 64, (r % nb) * 32, scr, F.lane); continue; } r -= I_QKV;
                if (r < I_O) { const int nb = DM / 32; transpose_item(attn_w_o, DM, DM, Wo_t, DM, (r % nb) * 32, (r / nb) * 64, (r % nb) * 32, scr, F.lane); continue; } r -= I_O;
                if (r < 2 * I_UP) { const int layer = r / I_UP; r -= layer * I_UP; const int nb = NUP / 32, n0 = (r % nb) * 32, k0 = (r / nb) * 64;
                    const int bj = n0 / DFF, f = n0 % DFF, dest = (f / 128) * 256 + bj * 128 + (f % 128);
                    transpose_item(ffn_w_up + (size_t)layer * DM * NUP, DM, NUP, Wup_t + (size_t)layer * NUP * DM, DM, dest, k0, n0, scr, F.lane); continue; } r -= 2 * I_UP;
                { const int layer = r / I_DN; r -= layer * I_DN; const int nb = DM / 32;
                    transpose_item(ffn_w_down + (size_t)layer * DFF * DM, DFF, DM, Wdn_t + (size_t)layer * DM * DFF, DFF, (r % nb) * 32, (r / nb) * 64, (r % nb) * 32, scr, F.lane); }
            }
        }
    }
    SEAM(0);
    if (IN(1)) row_pass<0>(F, x_prompt, x_sample, nullptr, nullptr, XN, nullptr, nullptr, norm_mix_pre, MOD + 0 * DM, MOD + 1 * DM);
    SEAM(1);
    if (IN(2)) { pg8::Gemm g{XN, Win_t, T_ALL, NIN, DM, DM, DM}; pg8::StaticOrder S; S.init(T_ALL, NIN, F.G, (int)blockIdx.x); pg8::EpiBf16 E{CV, NIN};
        pg8::gemm_phase<pg8::EpiBf16>(ring, xbuf, g, S, E); }
    SEAM(2);
    if (IN(3)) {
        for (int it = gw; it < (T_ALL / 8) * 2; it += NGW) {
            const int half = it & 1, t0 = (it >> 1) * 8, cb = half * 512 + 8 * F.lane;
            const int p0 = (t0 < T_CTX) ? (t0 & (SEQ_C - 1)) : ((t0 - T_CTX) & (SEQ_L - 1)), L = (t0 < T_CTX) ? SEQ_C : SEQ_L;
            float k0[8], k1[8], k2[8];
            { const f32x4 a = *(const f32x4*)(conv_k + cb), b = *(const f32x4*)(conv_k + cb + 4), c = *(const f32x4*)(conv_k + DM + cb), d = *(const f32x4*)(conv_k + DM + cb + 4),
                  e = *(const f32x4*)(conv_k + 2 * DM + cb), f = *(const f32x4*)(conv_k + 2 * DM + cb + 4);
#pragma unroll
              for (int j = 0; j < 4; ++j) { k0[j] = a[j]; k0[4 + j] = b[j]; k1[j] = c[j]; k1[4 + j] = d[j]; k2[j] = e[j]; k2[4 + j] = f[j]; } }
            float prev[8], cur[8], nxt[8];
#define PROD(dst, t) do { const u32x4 _c = *(const u32x4*)(CV + (size_t)(t) * NIN + DM + cb), _x = *(const u32x4*)(CV + (size_t)(t) * NIN + 2 * DM + cb); \
                _Pragma("unroll") for (int j = 0; j < 4; ++j) { dst[2 * j] = bflo(_c[j]) * bflo(_x[j]); dst[2 * j + 1] = bfhi(_c[j]) * bfhi(_x[j]); } } while (0)
#pragma unroll
            for (int j = 0; j < 8; ++j) prev[j] = 0.f;
            if (p0 > 0) PROD(prev, t0 - 1);
            PROD(cur, t0);
#pragma unroll
            for (int r = 0; r < 8; ++r) {
#pragma unroll
                for (int j = 0; j < 8; ++j) nxt[j] = 0.f;
                if (p0 + r + 1 < L) PROD(nxt, t0 + r + 1);
                bf16_t* bp = CV + (size_t)(t0 + r) * NIN + cb;
                const u32x4 bv = *(const u32x4*)bp; u32x4 o;
#pragma unroll
                for (int j = 0; j < 4; ++j) {
                    const float z0 = bflo(bv[j]) * fmaf(k2[2 * j], nxt[2 * j], fmaf(k1[2 * j], cur[2 * j], k0[2 * j] * prev[2 * j]));
                    const float z1 = bfhi(bv[j]) * fmaf(k2[2 * j + 1], nxt[2 * j + 1], fmaf(k1[2 * j + 1], cur[2 * j + 1], k0[2 * j + 1] * prev[2 * j + 1]));
                    o[j] = pk2(z0, z1); }
                *(u32x4*)bp = o;
#pragma unroll
                for (int j = 0; j < 8; ++j) { prev[j] = cur[j]; cur[j] = nxt[j]; }
            }
#undef PROD
        }
    }
    SEAM(3);
    if (IN(4)) { pg8::Gemm g{CV, Wout_t, T_ALL, DM, DM, NIN, DM}; pg8::StaticOrder S; S.init(T_ALL, DM, F.G, (int)blockIdx.x); pg8::EpiBf16 E{XN, DM};
        pg8::gemm_phase<pg8::EpiBf16>(ring, xbuf, g, S, E); }
    SEAM(4);
    if (IN(5)) row_pass<1>(F, x_prompt, x_sample, H, XN, XN, norm_mix_post, MOD + 2 * DM, norm_ffn_pre, MOD + 3 * DM, MOD + 4 * DM);
    SEAM(5);
#define FFN_UP(l) do { pg8::Gemm g{XN, Wup_t + (size_t)(l) * NUP * DM, T_ALL, NUP, DM, DM, DM}; pg8::StaticOrder S; S.init(T_ALL, NUP, F.G, (int)blockIdx.x); \
        pg8::EpiFfn E{A2, ffn_conv + (size_t)(l) * 3 * NUP, RAWB}; pg8::gemm_phase<pg8::EpiFfn>(ring, xbuf, g, S, E); } while (0)
#define FFN_FIX(l) do { const float* cw = ffn_conv + (size_t)(l) * 3 * NUP; \
        for (int it = gw; it < 56 * 2 * 11; it += NGW) { const int ch = it % 11, sel = (it / 11) & 1, bd = it / 22, lt = (bd / 7) * 8 + (bd % 7), f = ch * 256 + 4 * F.lane; \
            const float* rm = RAWB + (size_t)(lt * 4 + (sel ? 3 : 2)) * NUP; const float* rc = RAWB + (size_t)(sel ? (lt + 1) * 4 + 0 : lt * 4 + 3) * NUP; const float* rp = RAWB + (size_t)((lt + 1) * 4 + (sel ? 1 : 0)) * NUP; \
            const int row = T_CTX + 256 * (lt + sel) + (sel ? 0 : 255); float a[4]; \
            const f32x4 g0 = *(const f32x4*)(rm + f), g1 = *(const f32x4*)(rc + f), g2 = *(const f32x4*)(rp + f), u0 = *(const f32x4*)(rm + DFF + f), u1 = *(const f32x4*)(rc + DFF + f), u2 = *(const f32x4*)(rp + DFF + f); \
            const f32x4 wg0 = *(const f32x4*)(cw + f), wg1 = *(const f32x4*)(cw + NUP + f), wg2 = *(const f32x4*)(cw + 2 * NUP + f), wu0 = *(const f32x4*)(cw + DFF + f), wu1 = *(const f32x4*)(cw + NUP + DFF + f), wu2 = *(const f32x4*)(cw + 2 * NUP + DFF + f); \
            _Pragma("unroll") for (int j = 0; j < 4; ++j) { float gc = wg1[j] * g1[j]; gc = fmaf(g0[j], wg0[j], gc); gc = fmaf(g2[j], wg2[j], gc); float uc = wu1[j] * u1[j]; uc = fmaf(u0[j], wu0[j], uc); uc = fmaf(u2[j], wu2[j], uc); a[j] = silu_f(gc) * uc; } \
            u32x2 w; w.x = cvt_pk_bf16(a[0], a[1]); w.y = cvt_pk_bf16(a[2], a[3]); *(u32x2*)(A2 + (size_t)row * DFF + f) = w; } } while (0)
#define FFN_DOWN(l) do { pg8::Gemm g{A2, Wdn_t + (size_t)(l) * DM * DFF, T_ALL, DM, DFF, DFF, DFF}; pg8::StaticOrder S; S.init(T_ALL, DM, F.G, (int)blockIdx.x); pg8::EpiBf16 E{XN, DM}; \
        pg8::gemm_phase<pg8::EpiBf16>(ring, xbuf, g, S, E); } while (0)
    if (IN(6)) FFN_UP(0);
    SEAM(6);
    if (IN(7)) FFN_FIX(0);
    SEAM(7);
    if (IN(8)) FFN_DOWN(0);
    SEAM(8);
    if (IN(9)) row_pass<1>(F, H, H + (size_t)T_CTX * DM, H, XN, XN, norm_ffn_post, MOD + 5 * DM, norm_mix_pre + DM, MOD + (size_t)9 * NMOD + 0 * DM, MOD + (size_t)9 * NMOD + 1 * DM);
    SEAM(9);
    if (IN(10)) { pg8::Gemm g{XN, Wqkv_t, T_ALL, NQKV, DM, DM, DM}; pg8::StaticOrder S; S.init(T_ALL, NQKV, F.G, (int)blockIdx.x); pg8::EpiBf16 E{QKV, NQKV};
        pg8::gemm_phase<pg8::EpiBf16>(ring, xbuf, g, S, E); }
    SEAM(10);
    if (IN(11)) {
        for (size_t i = (size_t)gw * 64 + F.lane; i < (size_t)8 * PAST * KVW / 8; i += (size_t)NGW * 64) {
            const size_t e = i * 8; const int b = (int)(e / ((size_t)PAST * KVW)); const size_t w = e % ((size_t)PAST * KVW);
            const f32x4 k0 = *(const f32x4*)(cache_k + e), k1 = *(const f32x4*)(cache_k + e + 4), v0 = *(const f32x4*)(cache_v + e), v1 = *(const f32x4*)(cache_v + e + 4);
            u32x4 ko, vo; ko.x = pk2(k0[0], k0[1]); ko.y = pk2(k0[2], k0[3]); ko.z = pk2(k1[0], k1[1]); ko.w = pk2(k1[2], k1[3]);
            vo.x = pk2(v0[0], v0[1]); vo.y = pk2(v0[2], v0[3]); vo.z = pk2(v1[0], v1[1]); vo.w = pk2(v1[2], v1[3]);
            *(u32x4*)(KALL + (size_t)b * KV_LAT * KVW + w) = ko; *(u32x4*)(VALL + (size_t)b * KV_LAT * KVW + w) = vo;
        }
        const int cc = F.lane & 15;
        float qg[8], kg[8];
        { const f32x4 a = *(const f32x4*)(q_gain + 8 * cc), b = *(const f32x4*)(q_gain + 8 * cc + 4), c = *(const f32x4*)(k_gain + 8 * cc), d = *(const f32x4*)(k_gain + 8 * cc + 4);
#pragma unroll
          for (int j = 0; j < 4; ++j) { qg[j] = a[j]; qg[4 + j] = b[j]; kg[j] = c[j]; kg[4 + j] = d[j]; } }
        for (int t = gw; t < T_ALL; t += NGW) {
            const bool lat = t >= T_CTX; const int tl = t - T_CTX, bl = tl / SEQ_L, tt = tl % SEQ_L;
            float cs[8], sn[8];
            if (lat) { const int pos = (cc < 8) ? (tt >> 6) : (tt & 63); const float* rp = ROPE + ((size_t)pos * 32 + 8 * (cc & 3)) * 2;
                const f32x4 r0 = *(const f32x4*)rp, r1 = *(const f32x4*)(rp + 4), r2 = *(const f32x4*)(rp + 8), r3 = *(const f32x4*)(rp + 12);
                cs[0] = r0[0]; sn[0] = r0[1]; cs[1] = r0[2]; sn[1] = r0[3]; cs[2] = r1[0]; sn[2] = r1[1]; cs[3] = r1[2]; sn[3] = r1[3];
                cs[4] = r2[0]; sn[4] = r2[1]; cs[5] = r2[2]; sn[5] = r2[3]; cs[6] = r3[0]; sn[6] = r3[1]; cs[7] = r3[2]; sn[7] = r3[3]; }
            const float sgn = ((cc & 7) < 4) ? -1.f : 1.f;
#pragma unroll
            for (int k = 0; k < 3; ++k) {
                const int c = F.lane + 64 * k, head = c >> 4;
                const u32x4 raw = *(const u32x4*)(QKV + (size_t)t * NQKV + 8 * c);
                float x[8];
#pragma unroll
                for (int j = 0; j < 4; ++j) { x[2 * j] = bflo(raw[j]); x[2 * j + 1] = bfhi(raw[j]); }
                const bool isv = (k == 2) && (F.lane >= 32), isq = (k < 2);
                {
                    float s = 0.f;
#pragma unroll
                    for (int j = 0; j < 8; ++j) s = fmaf(x[j], x[j], s);
                    s += __shfl_xor(s, 1); s += __shfl_xor(s, 2); s += __shfl_xor(s, 4); s += __shfl_xor(s, 8);
                    const float rs = __builtin_amdgcn_rsqf(s * (1.0f / HD) + EPS);
#pragma unroll
                    for (int j = 0; j < 8; ++j) x[j] = isv ? x[j] : x[j] * rs * (isq ? qg[j] : kg[j]);
                }
                float y[8];
#pragma unroll
                for (int j = 0; j < 8; ++j) { const float p = __shfl_xor(x[j], 4); y[j] = (lat && !isv) ? fmaf(x[j], cs[j], sgn * p * sn[j]) : x[j]; }
                u32x4 o; o.x = pk2(y[0], y[1]); o.y = pk2(y[2], y[3]); o.z = pk2(y[4], y[5]); o.w = pk2(y[6], y[7]);
                if (isq) { *(u32x4*)(QB + (size_t)t * DM + 8 * c) = o; }
                else {
                    const int kvc = 8 * (c - 128 - (isv ? 32 : 0));
                    if (lat) { bf16_t* dst = (isv ? VALL : KALL) + ((size_t)bl * KV_LAT + PAST + tt) * KVW + kvc; *(u32x4*)dst = o; }
                    else { bf16_t* dst = (isv ? VC : KC) + (size_t)t * KVW + kvc; *(u32x4*)dst = o;
                        float* nd = (isv ? new_v : new_k) + (size_t)t * KVW + kvc;
                        *(f32x4*)nd = (f32x4){y[0], y[1], y[2], y[3]}; *(f32x4*)(nd + 4) = (f32x4){y[4], y[5], y[6], y[7]}; }
                }
            }
        }
    }
    SEAM(11);
    if (IN(12)) {
        char* albs = (char*)lds_raw;
        const int xg = (int)blockIdx.x & 7, j = (int)blockIdx.x >> 3;
        const int n_lat = 512, n_all = 512 + 256;
        for (int it0 = 0; ; ++it0) {
            int it;
            if (F.G == 256) { if (it0 >= 3) break; it = (it0 < 2) ? ((2 * xg + it0) * 32 + j) : (512 + F.vcu); }
            else { it = (int)blockIdx.x + it0 * F.G; if (it >= n_all) break; }
            const bf16_t *qp, *kp, *vp; bf16_t* op; int seq;
            if (it < n_lat) { const int grp = it >> 5, jj = it & 31, b = grp >> 1, kvh = grp & 1, h = kvh * 4 + (jj >> 3), qb = jj & 7;
                const size_t qo = ((size_t)(T_CTX + b * SEQ_L + qb * 256)) * DM + h * HD, ko = (size_t)b * KV_LAT * KVW + kvh * HD;
                qp = QB + qo; op = OB + qo; kp = KALL + ko; vp = VALL + ko; seq = KV_LAT; }
            else { const int ic = it - n_lat, b = ic >> 3, h = ic & 7, kvh = h >> 2;
                const size_t qo = (size_t)(b * SEQ_C) * DM + h * HD, ko = (size_t)(b * SEQ_C) * KVW + kvh * HD;
                qp = QB + qo; op = OB + qo; kp = KC + ko; vp = VC + ko; seq = SEQ_C; }
            __syncthreads();
            att::attn_dense_body(qp, kp, vp, op, seq, albs);
        }
        __syncthreads();
    }
    SEAM(12);
    if (IN(13)) { pg8::Gemm g{OB, Wo_t, T_ALL, DM, DM, DM, DM}; pg8::StaticOrder S; S.init(T_ALL, DM, F.G, (int)blockIdx.x); pg8::EpiBf16 E{XN, DM};
        pg8::gemm_phase<pg8::EpiBf16>(ring, xbuf, g, S, E); }
    SEAM(13);
    if (IN(14)) row_pass<1>(F, H, H + (size_t)T_CTX * DM, H, XN, XN, norm_mix_post + DM, MOD + (size_t)9 * NMOD + 2 * DM, norm_ffn_pre + DM, MOD + (size_t)9 * NMOD + 3 * DM, MOD + (size_t)9 * NMOD + 4 * DM);
    SEAM(14);
    if (IN(15)) FFN_UP(1);
    SEAM(15);
    if (IN(16)) FFN_FIX(1);
    SEAM(16);
    if (IN(17)) FFN_DOWN(1);
    SEAM(17);
    if (IN(18)) row_pass<2>(F, H, H + (size_t)T_CTX * DM, H, XN, nullptr, norm_ffn_post + DM, MOD + (size_t)9 * NMOD + 5 * DM, nullptr, nullptr, nullptr);
#undef IN
#undef SEAM
}

extern "C" void kernel_launch(void* const* d_in, const int* in_sizes, int n_in, void* d_out, int out_size, void* d_ws, size_t ws_size, hipStream_t stream) {
    static int grid = 0;
    if (grid == 0) {
        const long want_out = (long)T_ALL * DM + 2L * T_CTX * KVW;
        if (n_in != 22 || in_sizes[0] != T_CTX * DM || in_sizes[1] != T_LAT * DM || (long)out_size != want_out || ws_size < WS_END) {
            fprintf(stderr, "kernel_launch: shape mismatch (n_in %d out %d ws %zu)\n", n_in, out_size, ws_size); grid = -1; return; }
        int dev = 0, cus = 0;
        if (hipGetDevice(&dev) != hipSuccess || hipDeviceGetAttribute(&cus, hipDeviceAttributeMultiprocessorCount, dev) != hipSuccess) { grid = -1; return; }
        if (hipFuncSetAttribute((const void*)mega_fwd, hipFuncAttributeMaxDynamicSharedMemorySize, LDS_BYTES) != hipSuccess) { fprintf(stderr, "kernel_launch: hipFuncSetAttribute failed\n"); grid = -1; return; }
        int per_cu = 0;
        if (hipOccupancyMaxActiveBlocksPerMultiprocessor(&per_cu, (const void*)mega_fwd, 512, LDS_BYTES) != hipSuccess || per_cu < 1) fprintf(stderr, "kernel_launch: occupancy query says %d\n", per_cu);
        (void)hipGetLastError();
        grid = cus;
    }
    if (grid < 0) return;
    (void)hipMemsetAsync((char*)d_ws + WS_CTL, 0, CTL_ZERO_BYTES, stream);
    Args a{};
    for (int i = 0; i < 22; ++i) a.in[i] = (const float*)d_in[i];
    a.out = (float*)d_out; a.ws = (unsigned char*)d_ws;
#if MK_N_LAUNCHES == 1
    a.ph_lo = 0; a.ph_hi = N_PHASES;
    hipLaunchKernelGGL(mega_fwd, dim3(grid), dim3(512), LDS_BYTES, stream, a);
#else
    for (int p = 0; p < N_PHASES; ++p) { a.ph_lo = p; a.ph_hi = p + 1; hipLaunchKernelGGL(mega_fwd, dim3(grid), dim3(512), LDS_BYTES, stream, a); }
#endif
    const hipError_t le = hipPeekAtLastError();
    if (le != hipSuccess) fprintf(stderr, "kernel_launch: launch failed: %s\n", hipGetErrorName(le));
}
```

```cpp
#include <hip/hip_runtime.h>
#include <cstdio>
#include <cstdint>

#ifndef MK_N_LAUNCHES
#define MK_N_LAUNCHES 1
#endif
#define EPI_TWICE 0
#define PROBE_SUB 0
#define PROBE_MASK 0x0

#define GAS __attribute__((address_space(1)))
#define LAS __attribute__((address_space(3)))
typedef unsigned short bf16_t;
typedef short bf16x8 __attribute__((ext_vector_type(8)));
typedef short s16x4 __attribute__((ext_vector_type(4)));
typedef float f32x4 __attribute__((ext_vector_type(4)));
typedef float f32x2 __attribute__((ext_vector_type(2)));
typedef float f32x16 __attribute__((ext_vector_type(16)));
typedef unsigned u32x4 __attribute__((ext_vector_type(4)));
typedef unsigned u32x2 __attribute__((ext_vector_type(2)));

constexpr int DM = 1024, T_CTX = 8192, T_LAT = 16384, T_ALL = T_CTX + T_LAT, SEQ_C = 256, SEQ_L = 2048, PAST = 512, KV_LAT = PAST + SEQ_L;
constexpr int DFF = 2816, NUP = 2 * DFF, NQKV = 1536, NIN = 3072, NMOD = 6 * DM, HD = 128, NKVH = 2, NQH = 8, KVW = NKVH * HD;
constexpr float EPS = 1e-6f;

constexpr size_t MiB = 1u << 20;
constexpr size_t WS_CTL = 0, CTL_ZERO_BYTES = 64 * 1024;
constexpr size_t WS_MOD = 1 * MiB;
constexpr size_t WS_ROPE = 1 * MiB + 512 * 1024;
constexpr size_t WS_RAWB = 2 * MiB;
constexpr size_t WS_WIN = 8 * MiB, WS_WOUT = 14 * MiB, WS_WQKV = 16 * MiB, WS_WO = 19 * MiB, WS_WUP = 21 * MiB, WS_WDN = 43 * MiB;
constexpr size_t WS_XN = 54 * MiB;
constexpr size_t WS_BIG = 102 * MiB;
constexpr size_t WS_END = 250 * MiB;
constexpr size_t BIG_CV = 0;
constexpr size_t BIG_A2 = 0;
constexpr size_t BIG_QKV = 0, BIG_O = 0;
constexpr size_t BIG_Q = 72 * MiB, BIG_KALL = 120 * MiB, BIG_VALL = 130 * MiB, BIG_KC = 140 * MiB, BIG_VC = 144 * MiB;
constexpr int CW_BAR = 1024;

constexpr int RING_BYTES = 131072, XB_OFF = RING_BYTES, XB_BYTES = 8192, LDSCTL_OFF = XB_OFF + XB_BYTES, MISC_OFF = LDSCTL_OFF + 64, LDS_BYTES = 147456;

__device__ __forceinline__ unsigned f2bf(float f) { unsigned u = __builtin_bit_cast(unsigned, f); return (u + 0x7fffu + ((u >> 16) & 1u)) >> 16; }
__device__ __forceinline__ unsigned pk2(float lo, float hi) { return f2bf(lo) | (f2bf(hi) << 16); }
__device__ __forceinline__ float bflo(unsigned w) { return __builtin_bit_cast(float, w << 16); }
__device__ __forceinline__ float bfhi(unsigned w) { return __builtin_bit_cast(float, w & 0xffff0000u); }
__device__ __forceinline__ unsigned cvt_pk_bf16(float lo, float hi) { unsigned r; asm volatile("v_cvt_pk_bf16_f32 %0, %1, %2" : "=v"(r) : "v"(lo), "v"(hi)); return r; }
__device__ __forceinline__ float wave_sum(float v) {
#pragma unroll
    for (int o = 1; o < 64; o <<= 1) v += __shfl_xor(v, o);
    return v;
}
__device__ __forceinline__ float silu_f(float x) { const float e = __builtin_amdgcn_exp2f(-x * 1.4426950408889634f); return x * __builtin_amdgcn_rcpf(1.0f + e); }
#define LDS_WAIT() asm volatile("s_waitcnt lgkmcnt(0)" ::: "memory")
#define VM_WAIT() asm volatile("s_waitcnt vmcnt(0)" ::: "memory")

namespace pg8 {
constexpr int BM = 256, BK = 64, HALF = 128, HTB = HALF * BK * 2, STAGE_BYTES = 8 * HTB, NXCD = 8, WGM = 8;
__device__ __forceinline__ int lds_byte(int r, int c) { const int st = (r >> 4) * 2 + (c >> 5), rr = r & 15, cc = c & 31, ob = rr * 64 + cc * 2; return st * 1024 + (ob ^ (((ob >> 9) & 1) << 5)); }
__device__ __forceinline__ void stage_rc(int b, int& R, int& C) { const int st = b / 1024, sb = b % 1024, swz = sb ^ (((sb >> 9) & 1) << 5); R = (st >> 1) * 16 + swz / 64; C = (st & 1) * 32 + (swz % 64) / 2; }
__device__ __forceinline__ int perm32(int rho) { const int n = rho >> 4, i = rho & 15; return 8 * (i >> 2) + 4 * n + (i & 3); }

struct Unit { int pm, pn, half; };
struct Gemm { const bf16_t* A; const bf16_t* Bt; int M, N, K, lda, ldb; };

struct StaticOrder {
    int nM, nN, nwg, G, c, F, R; bool split;
    __device__ __forceinline__ void init(int M, int N, int G_, int c_, bool split_last = false) { nM = M / BM; nN = N / BM; nwg = nM * nN; G = G_; c = c_; F = nwg / G; R = nwg % G; split = split_last && R > 0 && 2 * R <= G; }
    __device__ __forceinline__ bool next(int i, Unit& u) const {
        long L;
        if (split && i >= F) { if (i > F || c >= 2 * R) return false; L = (long)F * G + (c >> 1); u.half = c & 1; }
        else { L = (long)i * G + c; if (L >= nwg) return false; u.half = -1; }
        int wgid = (int)L; { const int q = nwg / NXCD, r = nwg % NXCD, xcd = wgid % NXCD, off = wgid / NXCD; wgid = (xcd < r ? xcd * (q + 1) : r * (q + 1) + (xcd - r) * q) + off; }
        const int nig = WGM * nN, gid = wgid / nig, fm = gid * WGM, gsz = (nM - fm) < WGM ? (nM - fm) : WGM;
        u.pm = fm + ((wgid % nig) % gsz); u.pn = (wgid % nig) / gsz; return true;
    }
};

struct EpiBf16 {
    static constexpr bool PERM = true;
    __device__ __forceinline__ static int nstores(const Unit& u) { return u.half < 0 ? 16 : 8; }
    bf16_t* O; int ldc;
    __device__ __forceinline__ void operator()(const f32x4 (&acc)[2][2][4][2], const Unit& u, int wr, int wc, int fr, int fq, LAS unsigned char*, int) const {
        const int row0 = u.pm * BM + (u.half > 0 ? HALF : 0) + wr * 64 + fr; const int col0 = u.pn * BM + wc * 32 + 8 * fq;
#pragma unroll
        for (int ai = 0; ai < 2; ++ai) if (ai == 0 || u.half < 0)
#pragma unroll
            for (int m = 0; m < 4; ++m) { bf16_t* rowp = O + (size_t)(row0 + ai * HALF + m * 16) * ldc + col0;
#pragma unroll
                for (int bj = 0; bj < 2; ++bj) { const f32x4 v0 = acc[ai][bj][m][0], v1 = acc[ai][bj][m][1];
                    u32x4 w; w.x = cvt_pk_bf16(v0[0], v0[1]); w.y = cvt_pk_bf16(v0[2], v0[3]); w.z = cvt_pk_bf16(v1[0], v1[1]); w.w = cvt_pk_bf16(v1[2], v1[3]);
                    *(u32x4*)(rowp + bj * HALF) = w; } }
    }
};

__device__ __forceinline__ float dpp_shr1(float x) { return __builtin_bit_cast(float, __builtin_amdgcn_update_dpp(0, __builtin_bit_cast(int, x), 0x111, 0xf, 0xf, true)); }
__device__ __forceinline__ float dpp_shl1(float x) { return __builtin_bit_cast(float, __builtin_amdgcn_update_dpp(0, __builtin_bit_cast(int, x), 0x101, 0xf, 0xf, true)); }
__device__ __forceinline__ float dpp_ror1(float x) { return __builtin_bit_cast(float, __builtin_amdgcn_update_dpp(0, __builtin_bit_cast(int, x), 0x121, 0xf, 0xf, true)); }
__device__ __forceinline__ float dpp_ror15(float x) { return __builtin_bit_cast(float, __builtin_amdgcn_update_dpp(0, __builtin_bit_cast(int, x), 0x12F, 0xf, 0xf, true)); }

struct EpiFfn {
    static constexpr bool PERM = true;
    __device__ __forceinline__ static int nstores(const Unit&) { return 32; }
    bf16_t* A2; const float* cw; float* rawb;
    __device__ __forceinline__ void operator()(const f32x4 (&acc)[2][2][4][2], const Unit& u, int wr, int wc, int fr, int fq, LAS unsigned char* xb, int lane) const {
        (void)lane;
        const int ccol = wc * 32 + 8 * fq;
        const int f0 = u.pn * HALF + ccol;
        LAS float* XB = (LAS float*)xb;
        if (fr == 0) {
#pragma unroll
            for (int ai = 0; ai < 2; ++ai)
#pragma unroll
                for (int bj = 0; bj < 2; ++bj)
#pragma unroll
                    for (int n = 0; n < 2; ++n) *(LAS f32x4*)(XB + (ai * 4 + wr * 2 + 0) * 256 + bj * HALF + ccol + 4 * n) = acc[ai][bj][0][n];
        }
        if (fr == 15) {
#pragma unroll
            for (int ai = 0; ai < 2; ++ai)
#pragma unroll
                for (int bj = 0; bj < 2; ++bj)
#pragma unroll
                    for (int n = 0; n < 2; ++n) *(LAS f32x4*)(XB + (ai * 4 + wr * 2 + 1) * 256 + bj * HALF + ccol + 4 * n) = acc[ai][bj][3][n];
        }
        if (u.pm >= 32) {
            const int lt = u.pm - 32;
            if (wr == 0 && fr < 2) {
#pragma unroll
                for (int bj = 0; bj < 2; ++bj)
#pragma unroll
                    for (int n = 0; n < 2; ++n) *(f32x4*)(rawb + (size_t)(lt * 4 + fr) * NUP + bj * DFF + f0 + 4 * n) = acc[0][bj][0][n];
            }
            if (wr == 1 && fr >= 14) {
#pragma unroll
                for (int bj = 0; bj < 2; ++bj)
#pragma unroll
                    for (int n = 0; n < 2; ++n) *(f32x4*)(rawb + (size_t)(lt * 4 + fr - 12) * NUP + bj * DFF + f0 + 4 * n) = acc[1][bj][3][n];
            }
        }
        f32x4 w0[2][2], w1[2][2], w2[2][2];
#pragma unroll
        for (int n = 0; n < 2; ++n)
#pragma unroll
            for (int bj = 0; bj < 2; ++bj) { const float* p = cw + bj * DFF + f0 + 4 * n; w0[bj][n] = *(const f32x4*)p; w1[bj][n] = *(const f32x4*)(p + NUP); w2[bj][n] = *(const f32x4*)(p + 2 * NUP); }
        asm volatile("s_waitcnt lgkmcnt(0)" ::: "memory"); __builtin_amdgcn_s_barrier(); asm volatile("" ::: "memory");
        const float e0 = (fr == 0) ? 1.f : 0.f, e15 = (fr == 15) ? 1.f : 0.f;
#pragma unroll
        for (int n = 0; n < 2; ++n) {
#pragma unroll
            for (int ai = 0; ai < 2; ++ai) {
                const bool hasp = !(ai == 0 && wr == 0), hasn = !(ai == 1 && wr == 1);
                const int pslot = (wr == 1) ? (ai * 4 + 0 * 2 + 1) : (0 * 4 + 1 * 2 + 1);
                const int nslot = (wr == 0) ? (ai * 4 + 1 * 2 + 0) : (1 * 4 + 0 * 2 + 0);
                float cv[2][4][4];
#pragma unroll
                for (int bj = 0; bj < 2; ++bj) {
                    const f32x4 pe = hasp ? *(LAS f32x4*)(XB + pslot * 256 + bj * HALF + ccol + 4 * n) : (f32x4){0.f, 0.f, 0.f, 0.f};
                    const f32x4 ne = hasn ? *(LAS f32x4*)(XB + nslot * 256 + bj * HALF + ccol + 4 * n) : (f32x4){0.f, 0.f, 0.f, 0.f};
#pragma unroll
                    for (int j = 0; j < 4; ++j) {
                        const float a0 = w0[bj][n][j], a1 = w1[bj][n][j], a2 = w2[bj][n][j], a0e = a0 * e0, a2e = a2 * e15;
                        const float x0 = acc[ai][bj][0][n][j], x1 = acc[ai][bj][1][n][j], x2 = acc[ai][bj][2][n][j], x3 = acc[ai][bj][3][n][j];
                        float c0, c1, c2, c3;
                        asm volatile(
                            "s_nop 1\n\t"
                            "v_mul_f32 %0, %10, %4\n\t"
                            "v_mul_f32 %1, %10, %5\n\t"
                            "v_mul_f32 %2, %10, %6\n\t"
                            "v_mul_f32 %3, %10, %7\n\t"
                            "v_fmac_f32_dpp %0, %4, %9 row_shr:1 row_mask:0xf bank_mask:0xf bound_ctrl:1\n\t"
                            "v_fmac_f32_dpp %1, %5, %9 row_shr:1 row_mask:0xf bank_mask:0xf bound_ctrl:1\n\t"
                            "v_fmac_f32_dpp %2, %6, %9 row_shr:1 row_mask:0xf bank_mask:0xf bound_ctrl:1\n\t"
                            "v_fmac_f32_dpp %3, %7, %9 row_shr:1 row_mask:0xf bank_mask:0xf bound_ctrl:1\n\t"
                            "v_fmac_f32_dpp %0, %4, %11 row_shl:1 row_mask:0xf bank_mask:0xf bound_ctrl:1\n\t"
                            "v_fmac_f32_dpp %1, %5, %11 row_shl:1 row_mask:0xf bank_mask:0xf bound_ctrl:1\n\t"
                            "v_fmac_f32_dpp %2, %6, %11 row_shl:1 row_mask:0xf bank_mask:0xf bound_ctrl:1\n\t"
                            "v_fmac_f32_dpp %3, %7, %11 row_shl:1 row_mask:0xf bank_mask:0xf bound_ctrl:1\n\t"
                            "v_fmac_f32 %0, %8, %12\n\t"
                            "v_fmac_f32_dpp %1, %4, %12 row_ror:1 row_mask:0xf bank_mask:0xf\n\t"
                            "v_fmac_f32_dpp %2, %5, %12 row_ror:1 row_mask:0xf bank_mask:0xf\n\t"
                            "v_fmac_f32_dpp %3, %6, %12 row_ror:1 row_mask:0xf bank_mask:0xf\n\t"
                            "v_fmac_f32_dpp %0, %5, %13 row_ror:15 row_mask:0xf bank_mask:0xf\n\t"
                            "v_fmac_f32_dpp %1, %6, %13 row_ror:15 row_mask:0xf bank_mask:0xf\n\t"
                            "v_fmac_f32_dpp %2, %7, %13 row_ror:15 row_mask:0xf bank_mask:0xf\n\t"
                            "v_fmac_f32 %3, %14, %13"
                            : "=&v"(c0), "=&v"(c1), "=&v"(c2), "=&v"(c3)
                            : "v"(x0), "v"(x1), "v"(x2), "v"(x3), "v"(pe[j]), "v"(a0), "v"(a1), "v"(a2), "v"(a0e), "v"(a2e), "v"(ne[j]));
                        cv[bj][0][j] = c0; cv[bj][1][j] = c1; cv[bj][2][j] = c2; cv[bj][3][j] = c3;
                    }
                }
#pragma unroll
                for (int m = 0; m < 4; ++m) {
                    float a[4];
#pragma unroll
                    for (int j = 0; j < 4; ++j) a[j] = silu_f(cv[0][m][j]) * cv[1][m][j];
                    u32x2 w; w.x = cvt_pk_bf16(a[0], a[1]); w.y = cvt_pk_bf16(a[2], a[3]);
                    const int row = u.pm * BM + ai * HALF + wr * 64 + m * 16 + fr;
                    *(u32x2*)(A2 + (size_t)row * DFF + f0 + 4 * n) = w;
                }
            }
        }
    }
};

template <class Epi, bool ALIGN_EPI = true, bool SP2 = true>
__device__ __forceinline__ void gemm_phase(LAS unsigned char* lds, LAS unsigned char* xb, const Gemm g, const StaticOrder& S, const Epi& E, const int tid) {
    const int wid = __builtin_amdgcn_readfirstlane(tid >> 6), lane = tid & 63, wr = wid >> 2, wc = wid & 3, fr = lane & 15, fq = lane >> 4;
    const int K = g.K, nt = K / BK;
    unsigned voffA[2], voffB[2];
#pragma unroll
    for (int i = 0; i < 2; ++i) { int R, C; stage_rc(tid * 16 + i * 8192, R, C); const int Rb = Epi::PERM ? ((R & ~31) + perm32(R & 31)) : R;
        voffA[i] = (unsigned)(R * g.lda + C) * 2u; voffB[i] = (unsigned)(Rb * g.ldb + C) * 2u; }
    const size_t kstep = (size_t)(BK * 2);
    const size_t hstepA = (size_t)HALF * g.lda * 2, hstepB = (size_t)HALF * g.ldb * 2;
    const size_t tstepA = 2 * hstepA, tstepB = 2 * hstepB;
    const unsigned ldsw = (unsigned)wid * 1024u;
    const int aoff = lds_byte(wr * 64 + fr, fq * 8), boff = lds_byte(wc * 32 + fr, fq * 8);
#define PG8_SA(b, h) (((b) * 2 + (h)) * HTB)
#define PG8_SB(b, h) ((4 + (b) * 2 + (h)) * HTB)
#define PG8_STAGE(bufoff, gbase, voff) do { _Pragma("unroll") for (int _i = 0; _i < 2; ++_i) \
        __builtin_amdgcn_global_load_lds((const unsigned*)((const char*)(gbase) + (voff)[_i]), (LAS unsigned*)(lds + (bufoff) + ldsw + _i * 8192), 16, 0, 0); } while (0)
#define PG8_LDA(dst, b, h) do { _Pragma("unroll") for (int m = 0; m < 4; ++m) _Pragma("unroll") for (int k = 0; k < 2; ++k) dst[m][k] = *(const LAS bf16x8*)(lds + PG8_SA(b, h) + aoff + m * 2048 + k * 1024); } while (0)
#define PG8_LDB(dst, b, h) do { _Pragma("unroll") for (int n = 0; n < 2; ++n) _Pragma("unroll") for (int k = 0; k < 2; ++k) dst[n][k] = *(const LAS bf16x8*)(lds + PG8_SB(b, h) + boff + n * 2048 + k * 1024); } while (0)
#define PG8_MMA(ai, bj, At, Bt) do { __builtin_amdgcn_s_setprio(1); _Pragma("unroll") for (int m = 0; m < 4; ++m) _Pragma("unroll") for (int n = 0; n < 2; ++n) _Pragma("unroll") for (int k = 0; k < 2; ++k) \
        acc[ai][bj][m][n] = __builtin_amdgcn_mfma_f32_16x16x32_bf16(Bt[n][k], At[m][k], acc[ai][bj][m][n], 0, 0, 0); __builtin_amdgcn_s_setprio(0); } while (0)
#define PG8_WAIT_V(n) asm volatile("s_waitcnt vmcnt(" #n ")" ::: "memory")
#define PG8_WAIT_L(n) asm volatile("s_waitcnt lgkmcnt(" #n ")" ::: "memory")
#define PG8_BAR __builtin_amdgcn_s_barrier()
#define PG8_SCHED __builtin_amdgcn_sched_barrier(0)
    Unit cur, nxt; int ui = 0, relax = 0;
    if (!S.next(0, cur)) return;
    f32x4 acc[2][2][4][2];
#pragma unroll
    for (int a = 0; a < 2; ++a)
#pragma unroll
        for (int b = 0; b < 2; ++b)
#pragma unroll
            for (int m = 0; m < 4; ++m)
#pragma unroll
                for (int n = 0; n < 2; ++n) acc[a][b][m][n] = (f32x4){0.f, 0.f, 0.f, 0.f};
    bf16x8 At[4][2], B0[2][2], B1[2][2];
    const char* cA = (const char*)g.A + (size_t)cur.pm * tstepA + (cur.half > 0 ? hstepA : 0); const char* cB = (const char*)g.Bt + (size_t)cur.pn * tstepB;
    size_t chs = (cur.half < 0) ? hstepA : 0;
    if constexpr (SP2) {
        PG8_STAGE(PG8_SB(0, 0), cB, voffB); PG8_STAGE(PG8_SB(0, 1), cB + hstepB, voffB); PG8_STAGE(PG8_SA(0, 0), cA, voffA); PG8_STAGE(PG8_SA(0, 1), cA + chs, voffA);
        if (wr == 1) PG8_BAR;
        PG8_WAIT_V(2); PG8_BAR;
        PG8_STAGE(PG8_SB(1, 0), cB + kstep, voffB); PG8_STAGE(PG8_SA(1, 0), cA + kstep, voffA); PG8_STAGE(PG8_SB(1, 1), cB + hstepB + kstep, voffB);
        PG8_WAIT_V(6); PG8_BAR;
    } else {
        PG8_STAGE(PG8_SB(0, 0), cB, voffB); PG8_STAGE(PG8_SA(0, 0), cA, voffA); PG8_STAGE(PG8_SB(0, 1), cB + hstepB, voffB); PG8_STAGE(PG8_SA(0, 1), cA + chs, voffA);
        if (wr == 1) PG8_BAR;
        PG8_WAIT_V(4); PG8_BAR;
        PG8_STAGE(PG8_SB(1, 0), cB + kstep, voffB); PG8_STAGE(PG8_SA(1, 0), cA + kstep, voffA); PG8_STAGE(PG8_SB(1, 1), cB + hstepB + kstep, voffB);
        PG8_WAIT_V(6); PG8_BAR;
    }
    for (;;) {
        const bool has_next = S.next(ui + 1, nxt);
        const char* nA = has_next ? (const char*)g.A + (size_t)nxt.pm * tstepA + (nxt.half > 0 ? hstepA : 0) : cA; const char* nB = has_next ? (const char*)g.Bt + (size_t)nxt.pn * tstepB : cB;
        const size_t nhs = has_next ? ((nxt.half < 0) ? hstepA : 0) : chs;
        const bool full = cur.half < 0;
        for (int t = 0; t < nt; t += 2) {
            const bool last = (t == nt - 2);
            const char* a1 = cA + (size_t)(t + 1) * kstep;
            const char* a2 = last ? nA : cA + (size_t)(t + 2) * kstep; const char* b2 = last ? nB : cB + (size_t)(t + 2) * kstep;
            const char* a3 = a2 + kstep; const char* b3 = b2 + kstep;
            const size_t h2 = last ? nhs : chs;
            if constexpr (SP2) {
            int rel = __builtin_amdgcn_readfirstlane(relax); asm volatile("" : "+s"(rel));
#define PG8_WAIT_V8R() asm volatile("s_cmp_lt_i32 %0, 16\n\ts_cbranch_scc1 1f\n\ts_waitcnt vmcnt(24)\n\ts_branch 2f\n1:\n\ts_waitcnt vmcnt(8)\n2:" :: "s"(rel) : "memory", "scc")
            PG8_LDB(B0, 0, 0); PG8_LDB(B1, 0, 1); PG8_SCHED; PG8_LDA(At, 0, 0); PG8_STAGE(PG8_SA(1, 1), a1 + chs, voffA);
            PG8_WAIT_V8R(); PG8_WAIT_L(0); PG8_BAR; PG8_MMA(0, 0, At, B0); PG8_MMA(0, 1, At, B1); PG8_BAR; PG8_SCHED;
            if (full) PG8_LDA(At, 0, 1); PG8_STAGE(PG8_SB(0, 0), b2, voffB); PG8_STAGE(PG8_SB(0, 1), b2 + hstepB, voffB); PG8_STAGE(PG8_SA(0, 0), a2, voffA);
            PG8_WAIT_V8R(); PG8_WAIT_L(0); PG8_BAR; if (full) { PG8_MMA(1, 0, At, B0); PG8_MMA(1, 1, At, B1); } PG8_BAR; PG8_SCHED;
#undef PG8_WAIT_V8R
            PG8_LDB(B0, 1, 0); PG8_LDB(B1, 1, 1); PG8_SCHED; PG8_LDA(At, 1, 0); PG8_STAGE(PG8_SA(0, 1), a2 + h2, voffA);
            PG8_WAIT_V(8); PG8_WAIT_L(0); PG8_BAR; PG8_MMA(0, 0, At, B0); PG8_MMA(0, 1, At, B1); PG8_BAR; PG8_SCHED;
            if (full) PG8_LDA(At, 1, 1); PG8_STAGE(PG8_SB(1, 0), b3, voffB); PG8_STAGE(PG8_SB(1, 1), b3 + hstepB, voffB); PG8_STAGE(PG8_SA(1, 0), a3, voffA);
            PG8_WAIT_V(8); PG8_WAIT_L(0); PG8_BAR; if (full) { PG8_MMA(1, 0, At, B0); PG8_MMA(1, 1, At, B1); } PG8_BAR; PG8_SCHED;
            relax = 0; asm volatile("" : "+s"(relax));
            } else {
            static_assert(SP2, "the four-phase loop has no half-unit support");
            PG8_LDB(B0, 0, 0); PG8_SCHED; PG8_LDA(At, 0, 0); PG8_STAGE(PG8_SA(1, 1), a1 + hstepA, voffA);
            PG8_WAIT_L(8); PG8_BAR; PG8_WAIT_L(0); PG8_MMA(0, 0, At, B0); PG8_BAR; PG8_SCHED;
            PG8_LDB(B1, 0, 1); PG8_STAGE(PG8_SB(0, 0), b2, voffB);
            PG8_BAR; PG8_WAIT_L(0); PG8_MMA(0, 1, At, B1); PG8_BAR;
            PG8_LDA(At, 0, 1); PG8_STAGE(PG8_SA(0, 0), a2, voffA);
            PG8_BAR; PG8_WAIT_L(0); PG8_MMA(1, 0, At, B0); PG8_BAR; PG8_SCHED;
            PG8_STAGE(PG8_SB(0, 1), b2 + hstepB, voffB);
            PG8_WAIT_V(6); PG8_BAR; PG8_MMA(1, 1, At, B1); PG8_BAR;
            PG8_LDB(B0, 1, 0); PG8_SCHED; PG8_LDA(At, 1, 0); PG8_STAGE(PG8_SA(0, 1), a2 + hstepA, voffA);
            PG8_WAIT_L(8); PG8_BAR; PG8_WAIT_L(0); PG8_MMA(0, 0, At, B0); PG8_BAR; PG8_SCHED;
            PG8_LDB(B1, 1, 1); PG8_STAGE(PG8_SB(1, 0), b3, voffB);
            PG8_BAR; PG8_WAIT_L(0); PG8_MMA(0, 1, At, B1); PG8_BAR;
            PG8_LDA(At, 1, 1); PG8_STAGE(PG8_SA(1, 0), a3, voffA);
            PG8_BAR; PG8_WAIT_L(0); PG8_MMA(1, 0, At, B0); PG8_BAR; PG8_SCHED;
            PG8_STAGE(PG8_SB(1, 1), b3 + hstepB, voffB);
            PG8_WAIT_V(6); PG8_BAR; PG8_MMA(1, 1, At, B1); PG8_BAR;
            }
        }
        if constexpr (ALIGN_EPI) { if (wr == 0) PG8_BAR; }
        E(acc, cur, wr, wc, fr, fq, xb, lane);
#if EPI_TWICE
        asm volatile("" ::: "memory"); E(acc, cur, wr, wc, fr, fq, xb, lane);
#endif
        if (!has_next) break;
#pragma unroll
        for (int a = 0; a < 2; ++a)
#pragma unroll
            for (int b = 0; b < 2; ++b)
#pragma unroll
                for (int m = 0; m < 4; ++m)
#pragma unroll
                    for (int n = 0; n < 2; ++n) acc[a][b][m][n] = (f32x4){0.f, 0.f, 0.f, 0.f};
        relax = Epi::nstores(cur);
        cur = nxt; cA = nA; cB = nB; chs = nhs; ++ui;
        if constexpr (ALIGN_EPI) { if (wr == 1) PG8_BAR; }
    }
    PG8_WAIT_V(0);
    if constexpr (!ALIGN_EPI) { if (wr == 0) PG8_BAR; }
    PG8_BAR;
#undef PG8_SA
#undef PG8_SB
#undef PG8_STAGE
#undef PG8_LDA
#undef PG8_LDB
#undef PG8_MMA
#undef PG8_WAIT_V
#undef PG8_WAIT_L
#undef PG8_BAR
#undef PG8_SCHED
}
}

namespace att {
constexpr int D = 128, NW = 8, QBLK = 32, KVBLK = 64;
constexpr float SCALE = 0.088388347648318440f;
constexpr float THR = 8.f;
constexpr int LDQ = DM, LDK = KVW, LDO = DM;
constexpr size_t SHM_V = KVBLK * D * 2, SHM_K = KVBLK * D * 2, SHM_ATTN = 2 * SHM_V + 2 * SHM_K + NW * 64 * 4;
#define KSWZ(row, colB) ((row) * 256 + ((colB) ^ (((row) & 7) << 4)))
#define SBAR() __builtin_amdgcn_sched_barrier(0)
__device__ __forceinline__ int crow(int r, int hi) { return (r & 3) + 8 * (r >> 2) + 4 * hi; }
__device__ __forceinline__ unsigned cvtpk(float lo, float hi) { unsigned r; asm volatile("v_cvt_pk_bf16_f32 %0, %1, %2" : "=v"(r) : "v"(lo), "v"(hi)); return r; }
__device__ __forceinline__ bf16x8 ld8(const bf16_t* p) { return *reinterpret_cast<const bf16x8*>(p); }

__device__ __forceinline__ void partialSM(f32x16& p0, f32x16& p1, float& m_reg, float& mn, float& alpha) {
  constexpr float C = SCALE * 1.4426950408889634f;
  float pmax = p0[0];
#pragma unroll
  for (int r = 1; r < 16; ++r) pmax = fmaxf(pmax, p0[r]);
#pragma unroll
  for (int r = 0; r < 16; ++r) pmax = fmaxf(pmax, p1[r]);
  { auto rr = __builtin_amdgcn_permlane32_swap(__float_as_uint(pmax), __float_as_uint(pmax), false, false);
    pmax = fmaxf(__uint_as_float(rr[0]), __uint_as_float(rr[1])); }
  if (__builtin_expect(__all(pmax - m_reg <= THR / SCALE), 1)) { mn = m_reg; alpha = 1.f; }
  else { mn = fmaxf(m_reg, pmax); alpha = __builtin_amdgcn_exp2f((m_reg - mn) * C); m_reg = mn; }
  float mnC = -mn * C;
#pragma unroll
  for (int r = 0; r < 16; ++r) p0[r] = fmaf(p0[r], C, mnC);
#pragma unroll
  for (int r = 0; r < 16; ++r) p1[r] = fmaf(p1[r], C, mnC);
#pragma unroll
  for (int r = 0; r < 16; ++r) p0[r] = __builtin_amdgcn_exp2f(p0[r]);
}
__device__ __forceinline__ void finishSM(f32x16& p0, f32x16& p1, float alpha, float& l_reg, bf16x8& pa0, bf16x8& pa1, bf16x8& pa2, bf16x8& pa3) {
#pragma unroll
  for (int r = 0; r < 16; ++r) p1[r] = __builtin_amdgcn_exp2f(p1[r]);
  float ps = 0;
#pragma unroll
  for (int r = 0; r < 16; ++r) ps += p0[r];
#pragma unroll
  for (int r = 0; r < 16; ++r) ps += p1[r];
  { auto rr = __builtin_amdgcn_permlane32_swap(__float_as_uint(ps), __float_as_uint(ps), false, false);
    ps = __uint_as_float(rr[0]) + __uint_as_float(rr[1]); }
  l_reg = l_reg * alpha + ps;
#define PK4(P, BASE, OUT) do { unsigned a0 = cvtpk(P[BASE + 0], P[BASE + 1]), a1 = cvtpk(P[BASE + 2], P[BASE + 3]);   \
    unsigned b0 = cvtpk(P[BASE + 4], P[BASE + 5]), b1 = cvtpk(P[BASE + 6], P[BASE + 7]);                              \
    auto r0 = __builtin_amdgcn_permlane32_swap(a0, b0, false, false); auto r1 = __builtin_amdgcn_permlane32_swap(a1, b1, false, false); \
    u32x4 w = {r0[0], r1[0], r0[1], r1[1]}; OUT = *reinterpret_cast<bf16x8*>(&w); } while (0)
  PK4(p0, 0, pa0); PK4(p0, 8, pa1); PK4(p1, 0, pa2); PK4(p1, 8, pa3);
#undef PK4
}
__device__ __forceinline__ void qkt(f32x16& p0, f32x16& p1, const bf16_t* Ks, const bf16x8* qr, int r32, int hi) {
  p0 = f32x16{}; p1 = f32x16{};
#pragma unroll
  for (int d0 = 0; d0 < 8; ++d0) { int cb = (d0 * 16 + hi * 8) * 2;
    bf16x8 b0 = *reinterpret_cast<const bf16x8*>((const char*)Ks + KSWZ(r32, cb));
    bf16x8 b1 = *reinterpret_cast<const bf16x8*>((const char*)Ks + KSWZ(32 + r32, cb));
    p0 = __builtin_amdgcn_mfma_f32_32x32x16_bf16(b0, qr[d0], p0, 0, 0, 0);
    p1 = __builtin_amdgcn_mfma_f32_32x32x16_bf16(b1, qr[d0], p1, 0, 0, 0); }
}
__device__ __forceinline__ int v_st(int k, int c) { const int kk = (k & ~0xC) | ((k & 4) << 1) | ((k & 8) >> 1); return ((kk >> 3) * 4 + (c >> 5)) * 512 + ((kk & 7) * 32 + (c & 31)) * 2; }
__device__ __forceinline__ int v_rd_base(int lane) { return ((lane & 3) << 3) | (((lane >> 2) & 3) << 6) | (((lane >> 4) & 1) << 5) | (((lane >> 5) & 1) << 8); }
constexpr int v_rd_off(int d0, int ks, int half) { return d0 * 512 + ks * 4096 + half * 2048; }
template <int OFF> __device__ __forceinline__ s16x4 tr_read(int vb) {
  s16x4 r; asm volatile("ds_read_b64_tr_b16 %0, %1 offset:%2" : "=&v"(r) : "v"(vb), "i"(OFF) : "memory"); return r;
}
template <int D0> __device__ __forceinline__ void pv_one(f32x16& od, int vb, bf16x8 pa0, bf16x8 pa1, bf16x8 pa2, bf16x8 pa3) {
  const s16x4 l0 = tr_read<v_rd_off(D0, 0, 0)>(vb), h0 = tr_read<v_rd_off(D0, 0, 1)>(vb), l1 = tr_read<v_rd_off(D0, 1, 0)>(vb), h1 = tr_read<v_rd_off(D0, 1, 1)>(vb);
  const s16x4 l2 = tr_read<v_rd_off(D0, 2, 0)>(vb), h2 = tr_read<v_rd_off(D0, 2, 1)>(vb), l3 = tr_read<v_rd_off(D0, 3, 0)>(vb), h3 = tr_read<v_rd_off(D0, 3, 1)>(vb);
  asm volatile("s_waitcnt lgkmcnt(0)" ::: "memory"); SBAR();
#define PK(L, H) (bf16x8){L[0], L[1], L[2], L[3], H[0], H[1], H[2], H[3]}
  od = __builtin_amdgcn_mfma_f32_32x32x16_bf16(pa0, PK(l0, h0), od, 0, 0, 0);
  od = __builtin_amdgcn_mfma_f32_32x32x16_bf16(pa1, PK(l1, h1), od, 0, 0, 0);
  od = __builtin_amdgcn_mfma_f32_32x32x16_bf16(pa2, PK(l2, h2), od, 0, 0, 0);
  od = __builtin_amdgcn_mfma_f32_32x32x16_bf16(pa3, PK(l3, h3), od, 0, 0, 0);
#undef PK
}
__device__ __forceinline__ void pv_d0(f32x16* o, int vb, bf16x8 pa0, bf16x8 pa1, bf16x8 pa2, bf16x8 pa3) {
  pv_one<0>(o[0], vb, pa0, pa1, pa2, pa3); pv_one<1>(o[1], vb, pa0, pa1, pa2, pa3); pv_one<2>(o[2], vb, pa0, pa1, pa2, pa3); pv_one<3>(o[3], vb, pa0, pa1, pa2, pa3);
}

__device__ __forceinline__ void attn_dense_body(const bf16_t* __restrict__ Qb, const bf16_t* __restrict__ Kh, const bf16_t* __restrict__ Vh,
                                                bf16_t* __restrict__ Ob, int seq, char* lds, const int tid) {
  const int wid = tid >> 6, lane = tid & 63, r32 = lane & 31, hi = lane >> 5;
  bf16_t* V_lds = (bf16_t*)lds; bf16_t* K_lds = (bf16_t*)(lds + 2 * SHM_V);
  float* ws = (float*)(lds + 2 * SHM_V + 2 * SHM_K) + wid * 64; float* li_l = ws; float* al_l = ws + 32;
  float m_reg = -1e30f, l_reg = 0; f32x16 o[4] = {}; bf16x8 qr[8];
  const bf16_t* Qw = Qb + (long)(wid * QBLK + r32) * LDQ + hi * 8;
#pragma unroll
  for (int d0 = 0; d0 < 8; ++d0) qr[d0] = ld8(Qw + d0 * 16);
  const int sr = tid >> 4, sc = (tid & 15) * 8, vst0 = v_st(sr, sc), vst1 = v_st(32 + sr, sc);
  const int vb0 = (int)(uintptr_t)V_lds + v_rd_base(lane);
  struct { bf16x8 vs0, vs1, ks0, ks1; } sr_[2];
#define SLOAD(i, k0) do { sr_[i].vs0 = ld8(&Vh[(long)((k0) + sr) * LDK + sc]); sr_[i].vs1 = ld8(&Vh[(long)((k0) + 32 + sr) * LDK + sc]); \
    sr_[i].ks0 = ld8(&Kh[(long)((k0) + sr) * LDK + sc]); sr_[i].ks1 = ld8(&Kh[(long)((k0) + 32 + sr) * LDK + sc]); } while (0)
#define SWRITE(b, i) do { *(bf16x8*)((char*)V_lds + (b) * SHM_V + vst0) = sr_[i].vs0;          \
    *(bf16x8*)((char*)V_lds + (b) * SHM_V + vst1) = sr_[i].vs1; int kc = sc * 2;               \
    *(bf16x8*)((char*)K_lds + (b) * SHM_K + KSWZ(sr, kc)) = sr_[i].ks0;                       \
    *(bf16x8*)((char*)K_lds + (b) * SHM_K + KSWZ(32 + sr, kc)) = sr_[i].ks1; } while (0)
#define SWAIT() asm volatile("s_waitcnt vmcnt(4)" ::: "memory")
#define RESC(a) do { if (__any((a) < 1.f)) { if (hi == 0) al_l[r32] = (a); asm volatile("s_waitcnt lgkmcnt(0)" ::: "memory"); \
    _Pragma("unroll") for (int d = 0; d < 4; ++d) _Pragma("unroll") for (int r = 0; r < 16; ++r) o[d][r] *= al_l[crow(r, hi)]; } } while (0)
  f32x16 pA0, pA1, pB0, pB1; float mnA, mnB, alA, alB; bf16x8 pa0, pa1, pa2, pa3; const int NT = seq / KVBLK;
  constexpr int SE = 0, SO = 1;
  SLOAD(SE, 0); asm volatile("s_waitcnt vmcnt(0)" ::: "memory"); SWRITE(0, SE); __syncthreads();
  qkt(pA0, pA1, K_lds, qr, r32, hi); partialSM(pA0, pA1, m_reg, mnA, alA);
  SLOAD(SO, KVBLK); if (2 < NT) SLOAD(SE, 2 * KVBLK);
  SWAIT(); SWRITE(1, SO); __syncthreads();
  for (int j = 1; j + 1 < NT; j += 2) {
    SBAR(); qkt(pB0, pB1, (bf16_t*)((char*)K_lds + SHM_K), qr, r32, hi);
    finishSM(pA0, pA1, alA, l_reg, pa0, pa1, pa2, pa3); SBAR();
    SLOAD(SO, (j + 2) * KVBLK); SBAR();
    pv_d0(o, vb0, pa0, pa1, pa2, pa3); partialSM(pB0, pB1, m_reg, mnB, alB);
    __syncthreads(); SWAIT(); SWRITE(0, SE);
    RESC(alB); __syncthreads();
    SBAR(); qkt(pA0, pA1, K_lds, qr, r32, hi);
    finishSM(pB0, pB1, alB, l_reg, pa0, pa1, pa2, pa3); SBAR();
    if (j + 3 < NT) SLOAD(SE, (j + 3) * KVBLK); SBAR();
    pv_d0(o, vb0 + (int)SHM_V, pa0, pa1, pa2, pa3); partialSM(pA0, pA1, m_reg, mnA, alA);
    __syncthreads(); SWAIT(); SWRITE(1, SO);
    RESC(alA); __syncthreads();
  }
  SBAR(); qkt(pB0, pB1, (bf16_t*)((char*)K_lds + SHM_K), qr, r32, hi);
  finishSM(pA0, pA1, alA, l_reg, pa0, pa1, pa2, pa3); SBAR();
  pv_d0(o, vb0, pa0, pa1, pa2, pa3); partialSM(pB0, pB1, m_reg, mnB, alB);
  __syncthreads(); RESC(alB);
  finishSM(pB0, pB1, alB, l_reg, pa0, pa1, pa2, pa3); SBAR();
  pv_d0(o, vb0 + (int)SHM_V, pa0, pa1, pa2, pa3);
  if (hi == 0) li_l[r32] = l_reg; asm volatile("s_waitcnt lgkmcnt(0)" ::: "memory");
  float rli[16];
#pragma unroll
  for (int r = 0; r < 16; ++r) rli[r] = __builtin_amdgcn_rcpf(li_l[crow(r, hi)]);
  bf16_t* Ow = Ob + (long)(wid * QBLK) * LDO;
#pragma unroll
  for (int r = 0; r < 16; ++r) { int orow = crow(r, hi);
#pragma unroll
    for (int d0 = 0; d0 < 4; ++d0) Ow[(long)orow * LDO + d0 * 32 + r32] = (bf16_t)f2bf(o[d0][r] * rli[r]); }
#undef SLOAD
#undef SWRITE
#undef SWAIT
#undef RESC
}
#undef KSWZ
#undef SBAR
}

#define XB_TMO      128
#define XB_XCNT(j)  (256  + 64 * (j))
#define XB_XSUB(j)  (1280 + 64 * (j))
#define XB_XGEN(j)  (2304 + 64 * (j))
#define XB_TOP      3328
#define XB_TOPGEN   3392
#define XCD_BAR_WORDS 3456
#define XB_SPIN_CAP (1u << 18)
__device__ __forceinline__ unsigned xb_ld(unsigned* p)              { return __hip_atomic_load(p, __ATOMIC_RELAXED, __HIP_MEMORY_SCOPE_AGENT); }
__device__ __forceinline__ unsigned xb_add(unsigned* p, unsigned v) { return __hip_atomic_fetch_add(p, v, __ATOMIC_RELAXED, __HIP_MEMORY_SCOPE_AGENT); }
__device__ __forceinline__ unsigned xb_xcc_id() { return (unsigned)__builtin_amdgcn_s_getreg((3 << 11) | 20) & 0xFu; }
#define XB_SPIN(cond, bar) do { unsigned _sp = 0; while (cond) { __builtin_amdgcn_s_sleep(1); \
    if ((++_sp & 255u) == 0u) { if (xb_ld(&(bar)[XB_TMO])) break; if (_sp > XB_SPIN_CAP) { atomicAdd(&(bar)[XB_TMO], 1u); break; } } } } while (0)
struct XcdBarrier { unsigned* bar; unsigned x; volatile LAS unsigned* st; };
__device__ __forceinline__ XcdBarrier xcd_barrier_post(unsigned* bar, volatile LAS unsigned* st) {
    XcdBarrier b; b.bar = bar; b.x = xb_xcc_id(); b.st = st;
    if (threadIdx.x == 0) (void)xb_add(&bar[XB_XCNT(b.x)], 1u);
    return b;
}
__device__ __forceinline__ void xcd_barrier_complete(unsigned* bar, unsigned x, unsigned& nloc, unsigned& nx) {
    const unsigned G = gridDim.x * gridDim.y * gridDim.z;
    unsigned sum, cnt, mine, sp = 0u;
    for (;;) {
        sum = 0u; cnt = 0u; mine = 0u;
#pragma unroll
        for (unsigned j = 0; j < 16; ++j) { const unsigned c = xb_ld(&bar[XB_XCNT(j)]); sum += c; cnt += (c > 0u) ? 1u : 0u; mine = (j == x) ? c : mine; }
        if (sum == G) break;
        __builtin_amdgcn_s_sleep(1);
        if ((++sp & 255u) == 0u) { if (xb_ld(&bar[XB_TMO])) break; if (sp > XB_SPIN_CAP) { atomicAdd(&bar[XB_TMO], 1u); break; } }
    }
    nloc = mine > 0u ? mine : 1u; nx = cnt > 0u ? cnt : 1u;
}
__device__ __forceinline__ void xcd_barrier(const XcdBarrier& b) {
    asm volatile("s_waitcnt vmcnt(0)" ::: "memory");
    __syncthreads();
    if (threadIdx.x == 0) {
        unsigned* bar = b.bar;
        __builtin_amdgcn_s_waitcnt(0);
        unsigned nloc = b.st[0], nx = b.st[1];
        if (nloc == 0u) { xcd_barrier_complete(bar, b.x, nloc, nx); b.st[0] = nloc; b.st[1] = nx; }
        const unsigned old = xb_add(&bar[XB_XSUB(b.x)], 1u);
        const unsigned gen = old / nloc;
        if (old + 1u == (gen + 1u) * nloc) {
            __builtin_amdgcn_fence(__ATOMIC_RELEASE, "agent");
            asm volatile("s_waitcnt vmcnt(0)" ::: "memory");
            const unsigned og = xb_add(&bar[XB_TOP], 1u);
            const unsigned tg = og / nx;
            if (og + 1u == (tg + 1u) * nx) xb_add(&bar[XB_TOPGEN], 1u);
            else XB_SPIN(xb_ld(&bar[XB_TOPGEN]) == tg, bar);
            __builtin_amdgcn_fence(__ATOMIC_ACQUIRE, "agent");
            xb_add(&bar[XB_XGEN(b.x)], 1u);
            asm volatile("s_waitcnt vmcnt(0)" ::: "memory");
        } else {
            XB_SPIN(xb_ld(&bar[XB_XGEN(b.x)]) == gen, bar);
            __builtin_amdgcn_fence(__ATOMIC_ACQUIRE, "agent");
            asm volatile("s_waitcnt vmcnt(0)" ::: "memory");
        }
    }
    __syncthreads();
}

struct Args {
    const float* in[22]; float* out; unsigned char* ws; int ph_lo, ph_hi;
};
struct Frame {
    LAS unsigned char* lds; unsigned char* ws;
    int tid, lane, wave, vcu, G;
};

struct TrItem { const float* W; bf16_t* WT; int N, ldk, dest_row0, k0, n0; };
__device__ __forceinline__ void tr_load(const TrItem& t, f32x4 (&v)[8], int lane) {
    const int r = lane >> 3, c4 = lane & 7;
#pragma unroll
    for (int i = 0; i < 8; ++i) v[i] = *(const f32x4*)(t.W + (size_t)(t.k0 + 8 * i + r) * t.N + t.n0 + 4 * c4);
}
__device__ __forceinline__ void tr_finish(const TrItem& t, const f32x4 (&v)[8], LAS float* scr, int lane) {
    const int r = lane >> 3, c4 = lane & 7;
#pragma unroll
    for (int i = 0; i < 8; ++i)
#pragma unroll
        for (int q = 0; q < 4; ++q) scr[(4 * c4 + q) * 65 + 8 * i + r] = v[i][q];
    LDS_WAIT(); asm volatile("" ::: "memory");
    const int c = lane & 7;
#pragma unroll
    for (int j = 0; j < 4; ++j) { const int n = (lane >> 3) + 8 * j; const LAS float* s = scr + n * 65 + 8 * c;
        u32x4 o; o.x = pk2(s[0], s[1]); o.y = pk2(s[2], s[3]); o.z = pk2(s[4], s[5]); o.w = pk2(s[6], s[7]);
        *(u32x4*)(t.WT + (size_t)(t.dest_row0 + n) * t.ldk + t.k0 + 8 * c) = o; }
    LDS_WAIT(); asm volatile("" ::: "memory");
}

__device__ __forceinline__ void load16(const float* p, int lane, float (&v)[16]) {
    const f32x4 a = *(const f32x4*)(p + 8 * lane), b = *(const f32x4*)(p + 8 * lane + 4), c = *(const f32x4*)(p + 512 + 8 * lane), d = *(const f32x4*)(p + 512 + 8 * lane + 4);
#pragma unroll
    for (int j = 0; j < 4; ++j) { v[j] = a[j]; v[4 + j] = b[j]; v[8 + j] = c[j]; v[12 + j] = d[j]; }
}
__device__ __forceinline__ void store16f(float* p, int lane, const float (&v)[16]) {
    *(f32x4*)(p + 8 * lane) = (f32x4){v[0], v[1], v[2], v[3]}; *(f32x4*)(p + 8 * lane + 4) = (f32x4){v[4], v[5], v[6], v[7]};
    *(f32x4*)(p + 512 + 8 * lane) = (f32x4){v[8], v[9], v[10], v[11]}; *(f32x4*)(p + 512 + 8 * lane + 4) = (f32x4){v[12], v[13], v[14], v[15]};
}
__device__ __forceinline__ void load16bf(const bf16_t* p, int lane, float (&v)[16]) {
    const u32x4 a = *(const u32x4*)(p + 8 * lane), b = *(const u32x4*)(p + 512 + 8 * lane);
#pragma unroll
    for (int j = 0; j < 4; ++j) { v[2 * j] = bflo(a[j]); v[2 * j + 1] = bfhi(a[j]); v[8 + 2 * j] = bflo(b[j]); v[8 + 2 * j + 1] = bfhi(b[j]); }
}
__device__ __forceinline__ void store16bf(bf16_t* p, int lane, const float (&v)[16]) {
    u32x4 a, b;
#pragma unroll
    for (int j = 0; j < 4; ++j) { a[j] = pk2(v[2 * j], v[2 * j + 1]); b[j] = pk2(v[8 + 2 * j], v[8 + 2 * j + 1]); }
    *(u32x4*)(p + 8 * lane) = a; *(u32x4*)(p + 512 + 8 * lane) = b;
}
__device__ __forceinline__ float sumsq16(const float (&v)[16]) { float s = 0.f;
#pragma unroll
    for (int j = 0; j < 16; ++j) s = fmaf(v[j], v[j], s);
    return s; }

constexpr int HB_LD = 2 * DM;
template <int MODE, bool FIRST>
__device__ __forceinline__ void row_pass(const Frame& F, const float* x_ctx, const float* x_lat, bf16_t* hb, float* outf, const bf16_t* Y, bf16_t* XN,
                                         const float* gpost, const float* gate_mod, const float* gpre, const float* shift_mod, const float* scale_mod) {
    const int gw = F.vcu * 8 + F.wave, lane = F.lane;
    constexpr int RPW = 12;
    float pg[16], gt[16], ng[16], sc[16], sh[16];
    if (MODE != 0) load16(gpost, lane, pg);
    if (MODE != 2) load16(gpre, lane, ng);
    int curb = -1;
    for (int ch = gw; ch < T_ALL / RPW; ch += F.G * 8)
    for (int r = ch * RPW; r < ch * RPW + RPW; ++r) {
        const int b = (r < T_CTX) ? 8 : (r - T_CTX) / SEQ_L;
        if (b != curb) { curb = b;
            if (MODE != 0) load16(gate_mod + (size_t)b * NMOD, lane, gt);
            if (MODE != 2) { load16(scale_mod + (size_t)b * NMOD, lane, sc); load16(shift_mod + (size_t)b * NMOD, lane, sh);
#pragma unroll
                for (int j = 0; j < 16; ++j) sc[j] = (1.0f + sc[j]) * ng[j]; } }
        float h[16];
        if (MODE == 0 || FIRST) { const float* hp = (r < T_CTX) ? x_ctx + (size_t)r * DM : x_lat + (size_t)(r - T_CTX) * DM; load16(hp, lane, h); }
        else load16bf(hb + (size_t)r * HB_LD, lane, h);
        if (MODE != 0) {
            float y[16]; load16bf(Y + (size_t)r * DM, lane, y);
            const float rs = __builtin_amdgcn_rsqf(wave_sum(sumsq16(y)) * (1.0f / DM) + EPS);
#pragma unroll
            for (int j = 0; j < 16; ++j) h[j] = fmaf(gt[j], y[j] * rs * pg[j], h[j]);
            if (MODE == 1) store16bf(hb + (size_t)r * HB_LD, lane, h); else store16f(outf + (size_t)r * DM, lane, h);
        }
        if (MODE != 2) {
            const float rs = __builtin_amdgcn_rsqf(wave_sum(sumsq16(h)) * (1.0f / DM) + EPS);
            float x[16];
#pragma unroll
            for (int j = 0; j < 16; ++j) x[j] = fmaf(h[j] * rs, sc[j], sh[j]);
            store16bf(XN + (size_t)r * DM, lane, x);
        }
    }
}

__device__ __forceinline__ void sincos_d(double x, double& s, double& c) {
    const double k = __builtin_rint(x * 0.63661977236758134308);
    const double r = fma(-k, 6.123233995736766036e-17, fma(-k, 1.57079632679489655800, x));
    const double r2 = r * r;
    double sp = -7.647163731819816476e-13; sp = fma(sp, r2, 1.605904383682161460e-10); sp = fma(sp, r2, -2.505210838544171878e-08); sp = fma(sp, r2, 2.755731922398589065e-06);
    sp = fma(sp, r2, -1.984126984126984127e-04); sp = fma(sp, r2, 8.333333333333333333e-03); sp = fma(sp, r2, -1.666666666666666667e-01); sp = fma(sp * r2, r, r);
    double cp = 4.779477332387385297e-14; cp = fma(cp, r2, -1.147074559772972471e-11); cp = fma(cp, r2, 2.087675698786809898e-09); cp = fma(cp, r2, -2.755731922398589065e-07);
    cp = fma(cp, r2, 2.480158730158730159e-05); cp = fma(cp, r2, -1.388888888888888889e-03); cp = fma(cp, r2, 4.166666666666666667e-02); cp = fma(cp, r2, -0.5); cp = fma(cp, r2, 1.0);
    const int q = ((int)k) & 3;
    s = (q == 0) ? sp : (q == 1) ? cp : (q == 2) ? -sp : -cp;
    c = (q == 0) ? cp : (q == 1) ? -sp : (q == 2) ? -cp : sp;
}

constexpr int N_PHASES = 19;
__device__ __forceinline__ const float* kin_ptr(int i) {
    typedef __attribute__((address_space(4))) const char* kptr_t;
    kptr_t kp = (kptr_t)__builtin_amdgcn_kernarg_segment_ptr();
    asm volatile("" : "+s"(kp));
    typedef const float* fptr_t; typedef __attribute__((address_space(4))) const fptr_t* kfp_t;
    return *(kfp_t)(kp + 8 * i);
}

__global__ void __launch_bounds__(512, 2) mega_fwd(Args args) {
    extern __shared__ __attribute__((aligned(16))) unsigned char lds_raw[];
    Frame F;
    F.lds = (LAS unsigned char*)lds_raw; F.ws = args.ws;
    F.tid = threadIdx.x; F.lane = F.tid & 63; F.wave = __builtin_amdgcn_readfirstlane(F.tid >> 6);
    F.G = gridDim.x; { const int bx = blockIdx.x; F.vcu = (F.G % 8 == 0) ? (bx % 8) * (F.G / 8) + bx / 8 : bx; }
    unsigned char* ws = args.ws;
    unsigned* ctl = (unsigned*)(ws + WS_CTL);
    volatile LAS unsigned* MISC = (volatile LAS unsigned*)(F.lds + MISC_OFF);
    for (int u = F.tid; u < (LDS_BYTES - LDSCTL_OFF) / 4; u += 512) ((LAS unsigned*)(F.lds + LDSCTL_OFF))[u] = 0u;
    __syncthreads();
    XcdBarrier bar; bar.bar = ctl + CW_BAR; bar.x = 0; bar.st = nullptr;
#if MK_N_LAUNCHES == 1
    constexpr int lo = 0, hi = N_PHASES;
#else
    const int lo = args.ph_lo, hi = args.ph_hi;
#endif
    if (hi - lo > 1) bar = xcd_barrier_post(ctl + CW_BAR, MISC + 8);
#ifndef PH_MASK
#define PH_MASK 0x7ffff
#endif
#define IN(k) (((PH_MASK >> (k)) & 1) && lo <= (k) && (k) < hi)
#if PROBE_MASK
    unsigned long long pr_t0 = __builtin_amdgcn_s_memrealtime();
#define PROBE_END(k) do { if ((PROBE_MASK >> (k)) & 1) { const unsigned long long _t1 = __builtin_amdgcn_s_memrealtime(); const unsigned long long _d = _t1 - pr_t0; \
        while (__builtin_amdgcn_s_memrealtime() - _t1 < _d) __builtin_amdgcn_s_sleep(8); } } while (0)
#define PROBE_T0() pr_t0 = __builtin_amdgcn_s_memrealtime()
#else
#define PROBE_END(k) do { } while (0)
#define PROBE_T0() do { } while (0)
#endif
#define SEAM(k) do { PROBE_END(k); if (IN(k) && IN((k) + 1)) xcd_barrier(bar); PROBE_T0(); } while (0)

#define KIN(i) kin_ptr(i)
#define PH_BEGIN() do { int _t = threadIdx.x; asm volatile("" : "+v"(_t)); F.tid = _t; F.lane = _t & 63; } while (0)
    float* H = args.out;
    bf16_t* HB = (bf16_t*)args.out;
    float* new_k = args.out + (size_t)T_ALL * DM; float* new_v = new_k + (size_t)T_CTX * KVW;
    float* MOD = (float*)(ws + WS_MOD); float* ROPE = (float*)(ws + WS_ROPE); float* RAWB = (float*)(ws + WS_RAWB);
    bf16_t* Win_t = (bf16_t*)(ws + WS_WIN); bf16_t* Wout_t = (bf16_t*)(ws + WS_WOUT); bf16_t* Wqkv_t = (bf16_t*)(ws + WS_WQKV); bf16_t* Wo_t = (bf16_t*)(ws + WS_WO);
    bf16_t* Wup_t = (bf16_t*)(ws + WS_WUP); bf16_t* Wdn_t = (bf16_t*)(ws + WS_WDN);
    bf16_t* XN = (bf16_t*)(ws + WS_XN);
    unsigned char* big = ws + WS_BIG;
    bf16_t* CV = (bf16_t*)(big + BIG_CV); bf16_t* A2 = (bf16_t*)(big + BIG_A2); bf16_t* QKV = (bf16_t*)(big + BIG_QKV); bf16_t* OB = (bf16_t*)(big + BIG_O);
    bf16_t* QB = (bf16_t*)(big + BIG_Q); bf16_t* KALL = (bf16_t*)(big + BIG_KALL); bf16_t* VALL = (bf16_t*)(big + BIG_VALL); bf16_t* KC = (bf16_t*)(big + BIG_KC); bf16_t* VC = (bf16_t*)(big + BIG_VC);
    LAS unsigned char* ring = F.lds; LAS unsigned char* xbuf = F.lds + XB_OFF;
    const int gw = F.vcu * 8 + F.wave, NGW = F.G * 8;

    if (IN(0)) { PH_BEGIN();
        const float* const cvec = KIN(4); const float* const c_ctx = KIN(5); const float* const mod_w = KIN(6); const float* const mod_b = KIN(7);
#if PROBE_SUB == 1
        unsigned long long ps0 = __builtin_amdgcn_s_memrealtime();
#endif
        {
            LAS float* sl = (LAS float*)ring;
            for (int it = F.vcu; it < 256; it += F.G) {
                const int layer = it >> 7, cchunk = (it >> 4) & 7, kchunk = it & 15, k0 = kchunk * 64;
                __syncthreads();
                for (int e = F.tid; e < 9 * 64; e += 512) { const int r = e >> 6, k = e & 63; const float v = (r < 8) ? cvec[r * DM + k0 + k] : c_ctx[k0 + k]; sl[e] = silu_f(v); }
                __syncthreads();
                const int ln = (F.lane < 48) ? F.lane : F.lane - 48, n = cchunk * 768 + F.wave * 96 + 2 * ln;
                const float* wp = mod_w + ((size_t)layer * DM + k0) * NMOD + n;
                f32x2 a[9];
#pragma unroll
                for (int r = 0; r < 9; ++r) a[r] = (f32x2){0.f, 0.f};
#pragma unroll 4
                for (int k = 0; k < 64; k += 4) {
                    const f32x2 wa = *(const f32x2*)(wp + (size_t)k * NMOD), wb = *(const f32x2*)(wp + (size_t)(k + 1) * NMOD), wc2 = *(const f32x2*)(wp + (size_t)(k + 2) * NMOD), wd = *(const f32x2*)(wp + (size_t)(k + 3) * NMOD);
#pragma unroll
                    for (int r = 0; r < 9; ++r) { const f32x4 s4 = *(const LAS f32x4*)(sl + r * 64 + k); a[r] = a[r] + wa * s4[0] + wb * s4[1] + wc2 * s4[2] + wd * s4[3]; } }
                if (F.lane < 48) {
                    const f32x2 bias = (kchunk == 0) ? *(const f32x2*)(mod_b + layer * NMOD + n) : (f32x2){0.f, 0.f};
#pragma unroll
                    for (int r = 0; r < 9; ++r) { float* d = MOD + ((size_t)layer * 9 + r) * NMOD + n; atomicAdd(d, a[r].x + bias.x); atomicAdd(d + 1, a[r].y + bias.y); }
                }
            }
            __syncthreads();
        }
#if PROBE_SUB == 1
        { const unsigned long long t1 = __builtin_amdgcn_s_memrealtime(), d = t1 - ps0; while (__builtin_amdgcn_s_memrealtime() - t1 < d) __builtin_amdgcn_s_sleep(8); }
#endif
        if (F.vcu == F.G - 1) {
            for (int e = F.tid; e < 64 * 32; e += 512) { const int pos = e >> 5, i = e & 31;
                double inv = 1.0; for (int q = 0; q < i; ++q) inv *= 0.74989420933245582730;
                double s, c; sincos_d((double)pos * inv, s, c);
                ROPE[2 * e] = (float)c; ROPE[2 * e + 1] = (float)s; }
        }
        {
#if PROBE_SUB == 2
        unsigned long long ps0 = __builtin_amdgcn_s_memrealtime();
#endif
            LAS float* scr = (LAS float*)(ring + F.wave * 16384);
            constexpr int I_IN = 16 * (NIN / 32), I_OUT = 16 * (DM / 32), I_QKV = 16 * (NQKV / 32), I_O = 16 * (DM / 32), I_UP = 16 * (NUP / 32), I_DN = (DFF / 64) * (DM / 32);
            constexpr int NITEMS = I_IN + I_OUT + I_QKV + I_O + 2 * I_UP + 2 * I_DN;
            const float* const conv_w_in = KIN(12); const float* const conv_w_out = KIN(14); const float* const attn_w_qkv = KIN(15); const float* const attn_w_o = KIN(18);
            const float* const ffn_w_up = KIN(19); const float* const ffn_w_down = KIN(21);
            auto item_of = [&](int it) -> TrItem {
                int r = it;
                if (r < I_IN) { const int nb = NIN / 32; return TrItem{conv_w_in, Win_t, NIN, DM, (r % nb) * 32, (r / nb) * 64, (r % nb) * 32}; } r -= I_IN;
                if (r < I_OUT) { const int nb = DM / 32; return TrItem{conv_w_out, Wout_t, DM, DM, (r % nb) * 32, (r / nb) * 64, (r % nb) * 32}; } r -= I_OUT;
                if (r < I_QKV) { const int nb = NQKV / 32; return TrItem{attn_w_qkv, Wqkv_t, NQKV, DM, (r % nb) * 32, (r / nb) * 64, (r % nb) * 32}; } r -= I_QKV;
                if (r < I_O) { const int nb = DM / 32; return TrItem{attn_w_o, Wo_t, DM, DM, (r % nb) * 32, (r / nb) * 64, (r % nb) * 32}; } r -= I_O;
                if (r < 2 * I_UP) { const int layer = r / I_UP; r -= layer * I_UP; const int nb = NUP / 32, n0 = (r % nb) * 32, k0 = (r / nb) * 64;
                    const int bj = n0 / DFF, f = n0 % DFF, dest = (f / 128) * 256 + bj * 128 + (f % 128);
                    return TrItem{ffn_w_up + (size_t)layer * DM * NUP, Wup_t + (size_t)layer * NUP * DM, NUP, DM, dest, k0, n0}; } r -= 2 * I_UP;
                { const int layer = r / I_DN; r -= layer * I_DN; const int nb = DM / 32;
                    return TrItem{ffn_w_down + (size_t)layer * DFF * DM, Wdn_t + (size_t)layer * DM * DFF, DM, DFF, (r % nb) * 32, (r / nb) * 64, (r % nb) * 32}; }
            };
            if (gw < NITEMS) {
                f32x4 va[8], vb[8]; TrItem ta = item_of(gw), tb = ta; tr_load(ta, va, F.lane);
                for (int it = gw; it < NITEMS; it += 2 * NGW) {
                    const bool hb = it + NGW < NITEMS; if (hb) { tb = item_of(it + NGW); tr_load(tb, vb, F.lane); }
                    tr_finish(ta, va, scr, F.lane);
                    if (!hb) break;
                    const bool ha = it + 2 * NGW < NITEMS; if (ha) { ta = item_of(it + 2 * NGW); tr_load(ta, va, F.lane); }
                    tr_finish(tb, vb, scr, F.lane);
                    if (!ha) break;
                }
            }
#if PROBE_SUB == 2
        { const unsigned long long t1 = __builtin_amdgcn_s_memrealtime(), d = t1 - ps0; while (__builtin_amdgcn_s_memrealtime() - t1 < d) __builtin_amdgcn_s_sleep(8); }
#endif
        }
    }
    SEAM(0);
    if (IN(1)) { PH_BEGIN(); row_pass<0, true>(F, KIN(0), KIN(1), nullptr, nullptr, nullptr, XN, nullptr, nullptr, KIN(8), MOD + 0 * DM, MOD + 1 * DM); }
    SEAM(1);
    if (IN(2)) { PH_BEGIN(); pg8::Gemm g{XN, Win_t, T_ALL, NIN, DM, DM, DM}; pg8::StaticOrder S; S.init(T_ALL, NIN, F.G, (int)blockIdx.x, true); pg8::EpiBf16 E{CV, NIN};
        pg8::gemm_phase<pg8::EpiBf16>(ring, xbuf, g, S, E, F.tid); }
    SEAM(2);
    if (IN(3)) { PH_BEGIN();
        const float* const conv_k = KIN(13);
        for (int it = gw; it < (T_ALL / 8) * 2; it += NGW) {
            const int half = it & 1, t0 = (it >> 1) * 8, cb = half * 512 + 8 * F.lane;
            const int p0 = (t0 < T_CTX) ? (t0 & (SEQ_C - 1)) : ((t0 - T_CTX) & (SEQ_L - 1)), L = (t0 < T_CTX) ? SEQ_C : SEQ_L;
            float k0[8], k1[8], k2[8];
            { const f32x4 a = *(const f32x4*)(conv_k + cb), b = *(const f32x4*)(conv_k + cb + 4), c = *(const f32x4*)(conv_k + DM + cb), d = *(const f32x4*)(conv_k + DM + cb + 4),
                  e = *(const f32x4*)(conv_k + 2 * DM + cb), f = *(const f32x4*)(conv_k + 2 * DM + cb + 4);
#pragma unroll
              for (int j = 0; j < 4; ++j) { k0[j] = a[j]; k0[4 + j] = b[j]; k1[j] = c[j]; k1[4 + j] = d[j]; k2[j] = e[j]; k2[4 + j] = f[j]; } }
            float prev[8], cur[8], nxt[8];
#define PROD(dst, t) do { const u32x4 _c = *(const u32x4*)(CV + (size_t)(t) * NIN + DM + cb), _x = *(const u32x4*)(CV + (size_t)(t) * NIN + 2 * DM + cb); \
                _Pragma("unroll") for (int j = 0; j < 4; ++j) { dst[2 * j] = bflo(_c[j]) * bflo(_x[j]); dst[2 * j + 1] = bfhi(_c[j]) * bfhi(_x[j]); } } while (0)
#pragma unroll
            for (int j = 0; j < 8; ++j) prev[j] = 0.f;
            if (p0 > 0) PROD(prev, t0 - 1);
            PROD(cur, t0);
#pragma unroll
            for (int r = 0; r < 8; ++r) {
#pragma unroll
                for (int j = 0; j < 8; ++j) nxt[j] = 0.f;
                if (p0 + r + 1 < L) PROD(nxt, t0 + r + 1);
                bf16_t* bp = CV + (size_t)(t0 + r) * NIN + cb;
                const u32x4 bv = *(const u32x4*)bp; u32x4 o;
#pragma unroll
                for (int j = 0; j < 4; ++j) {
                    const float z0 = bflo(bv[j]) * fmaf(k2[2 * j], nxt[2 * j], fmaf(k1[2 * j], cur[2 * j], k0[2 * j] * prev[2 * j]));
                    const float z1 = bfhi(bv[j]) * fmaf(k2[2 * j + 1], nxt[2 * j + 1], fmaf(k1[2 * j + 1], cur[2 * j + 1], k0[2 * j + 1] * prev[2 * j + 1]));
                    o[j] = pk2(z0, z1); }
                *(u32x4*)bp = o;
#pragma unroll
                for (int j = 0; j < 8; ++j) { prev[j] = cur[j]; cur[j] = nxt[j]; }
            }
#undef PROD
        }
    }
    SEAM(3);
    if (IN(4)) { PH_BEGIN(); pg8::Gemm g{CV, Wout_t, T_ALL, DM, DM, NIN, DM}; pg8::StaticOrder S; S.init(T_ALL, DM, F.G, (int)blockIdx.x, true); pg8::EpiBf16 E{XN, DM};
        pg8::gemm_phase<pg8::EpiBf16>(ring, xbuf, g, S, E, F.tid); }
    SEAM(4);
    if (IN(5)) { PH_BEGIN(); row_pass<1, true>(F, KIN(0), KIN(1), HB, nullptr, XN, XN, KIN(9), MOD + 2 * DM, KIN(10), MOD + 3 * DM, MOD + 4 * DM); }
    SEAM(5);
#define FFN_UP(l) do { pg8::Gemm g{XN, Wup_t + (size_t)(l) * NUP * DM, T_ALL, NUP, DM, DM, DM}; pg8::StaticOrder S; S.init(T_ALL, NUP, F.G, (int)blockIdx.x); \
        pg8::EpiFfn E{A2, KIN(20) + (size_t)(l) * 3 * NUP, RAWB}; pg8::gemm_phase<pg8::EpiFfn>(ring, xbuf, g, S, E, F.tid); } while (0)
#define FFN_FIX_ROW(cw, lt, sel) do { \
        const float* rm = RAWB + (size_t)((lt) * 4 + ((sel) ? 3 : 2)) * NUP; const float* rc = RAWB + (size_t)((sel) ? ((lt) + 1) * 4 + 0 : (lt) * 4 + 3) * NUP; const float* rp = RAWB + (size_t)(((lt) + 1) * 4 + ((sel) ? 1 : 0)) * NUP; \
        const int row = T_CTX + 256 * ((lt) + (sel)) + ((sel) ? 0 : 255); \
        for (int f = 4 * F.tid; f < DFF; f += 2048) { float a[4]; \
            const f32x4 g0 = *(const f32x4*)(rm + f), g1 = *(const f32x4*)(rc + f), g2 = *(const f32x4*)(rp + f), u0 = *(const f32x4*)(rm + DFF + f), u1 = *(const f32x4*)(rc + DFF + f), u2 = *(const f32x4*)(rp + DFF + f); \
            const f32x4 wg0 = *(const f32x4*)((cw) + f), wg1 = *(const f32x4*)((cw) + NUP + f), wg2 = *(const f32x4*)((cw) + 2 * NUP + f), wu0 = *(const f32x4*)((cw) + DFF + f), wu1 = *(const f32x4*)((cw) + NUP + DFF + f), wu2 = *(const f32x4*)((cw) + 2 * NUP + DFF + f); \
            _Pragma("unroll") for (int j = 0; j < 4; ++j) { float gc = wg1[j] * g1[j]; gc = fmaf(g0[j], wg0[j], gc); gc = fmaf(g2[j], wg2[j], gc); float uc = wu1[j] * u1[j]; uc = fmaf(u0[j], wu0[j], uc); uc = fmaf(u2[j], wu2[j], uc); a[j] = silu_f(gc) * uc; } \
            u32x2 w; w.x = cvt_pk_bf16(a[0], a[1]); w.y = cvt_pk_bf16(a[2], a[3]); *(u32x2*)(A2 + (size_t)row * DFF + f) = w; } } while (0)
#define FFN_DOWN(l) do { pg8::Gemm g{A2, Wdn_t + (size_t)(l) * DM * DFF, T_ALL, DM, DFF, DFF, DFF}; pg8::StaticOrder S; S.init(T_ALL, DM, F.G, (int)blockIdx.x, true); pg8::EpiBf16 E{XN, DM}; \
        { const float* cw = KIN(20) + (size_t)(l) * 3 * NUP; pg8::Unit uu; \
          for (int i = 0; S.next(i, uu); ++i) if (uu.pm >= 32) { const int lt = uu.pm - 32, ti = lt & 7; \
              if (ti != 0 && uu.half != 1) FFN_FIX_ROW(cw, lt - 1, 1);        \
              if (ti != 7 && uu.half != 0) FFN_FIX_ROW(cw, lt, 0); }           \
          VM_WAIT(); __syncthreads(); } \
        pg8::gemm_phase<pg8::EpiBf16>(ring, xbuf, g, S, E, F.tid); } while (0)
    if (IN(6)) { PH_BEGIN(); FFN_UP(0); }
    SEAM(6);
    if (IN(8)) { PH_BEGIN(); FFN_DOWN(0); }
    SEAM(8);
    if (IN(9)) { PH_BEGIN(); row_pass<1, false>(F, nullptr, nullptr, HB, nullptr, XN, XN, KIN(11), MOD + 5 * DM, KIN(8) + DM, MOD + (size_t)9 * NMOD + 0 * DM, MOD + (size_t)9 * NMOD + 1 * DM); }
    SEAM(9);
    if (IN(10)) { PH_BEGIN(); pg8::Gemm g{XN, Wqkv_t, T_ALL, NQKV, DM, DM, DM}; pg8::StaticOrder S; S.init(T_ALL, NQKV, F.G, (int)blockIdx.x, true); pg8::EpiBf16 E{QKV, NQKV};
        pg8::gemm_phase<pg8::EpiBf16>(ring, xbuf, g, S, E, F.tid); }
    SEAM(10);
    if (IN(11)) { PH_BEGIN();
        const float* const cache_k = KIN(2); const float* const cache_v = KIN(3); const float* const q_gain = KIN(16); const float* const k_gain = KIN(17);
        for (size_t i = (size_t)gw * 64 + F.lane; i < (size_t)8 * PAST * KVW / 8; i += (size_t)NGW * 64) {
            const size_t e = i * 8; const int b = (int)(e / ((size_t)PAST * KVW)); const size_t w = e % ((size_t)PAST * KVW);
            const f32x4 k0 = *(const f32x4*)(cache_k + e), k1 = *(const f32x4*)(cache_k + e + 4), v0 = *(const f32x4*)(cache_v + e), v1 = *(const f32x4*)(cache_v + e + 4);
            u32x4 ko, vo; ko.x = pk2(k0[0], k0[1]); ko.y = pk2(k0[2], k0[3]); ko.z = pk2(k1[0], k1[1]); ko.w = pk2(k1[2], k1[3]);
            vo.x = pk2(v0[0], v0[1]); vo.y = pk2(v0[2], v0[3]); vo.z = pk2(v1[0], v1[1]); vo.w = pk2(v1[2], v1[3]);
            *(u32x4*)(KALL + (size_t)b * KV_LAT * KVW + w) = ko; *(u32x4*)(VALL + (size_t)b * KV_LAT * KVW + w) = vo;
        }
        const int cc = F.lane & 15;
        float qg[8], kg[8];
        { const f32x4 a = *(const f32x4*)(q_gain + 8 * cc), b = *(const f32x4*)(q_gain + 8 * cc + 4), c = *(const f32x4*)(k_gain + 8 * cc), d = *(const f32x4*)(k_gain + 8 * cc + 4);
#pragma unroll
          for (int j = 0; j < 4; ++j) { qg[j] = a[j]; qg[4 + j] = b[j]; kg[j] = c[j]; kg[4 + j] = d[j]; } }
        for (int t = gw; t < T_ALL; t += NGW) {
            const bool lat = t >= T_CTX; const int tl = t - T_CTX, bl = tl / SEQ_L, tt = tl % SEQ_L;
            float cs[8], sn[8];
            if (lat) { const int pos = (cc < 8) ? (tt >> 6) : (tt & 63); const float* rp = ROPE + ((size_t)pos * 32 + 8 * (cc & 3)) * 2;
                const f32x4 r0 = *(const f32x4*)rp, r1 = *(const f32x4*)(rp + 4), r2 = *(const f32x4*)(rp + 8), r3 = *(const f32x4*)(rp + 12);
                cs[0] = r0[0]; sn[0] = r0[1]; cs[1] = r0[2]; sn[1] = r0[3]; cs[2] = r1[0]; sn[2] = r1[1]; cs[3] = r1[2]; sn[3] = r1[3];
                cs[4] = r2[0]; sn[4] = r2[1]; cs[5] = r2[2]; sn[5] = r2[3]; cs[6] = r3[0]; sn[6] = r3[1]; cs[7] = r3[2]; sn[7] = r3[3]; }
            const float sgn = ((cc & 7) < 4) ? -1.f : 1.f;
#pragma unroll
            for (int k = 0; k < 3; ++k) {
                const int c = F.lane + 64 * k, head = c >> 4;
                const u32x4 raw = *(const u32x4*)(QKV + (size_t)t * NQKV + 8 * c);
                float x[8];
#pragma unroll
                for (int j = 0; j < 4; ++j) { x[2 * j] = bflo(raw[j]); x[2 * j + 1] = bfhi(raw[j]); }
                const bool isv = (k == 2) && (F.lane >= 32), isq = (k < 2);
                {
                    float s = 0.f;
#pragma unroll
                    for (int j = 0; j < 8; ++j) s = fmaf(x[j], x[j], s);
                    s += __shfl_xor(s, 1); s += __shfl_xor(s, 2); s += __shfl_xor(s, 4); s += __shfl_xor(s, 8);
                    const float rs = __builtin_amdgcn_rsqf(s * (1.0f / HD) + EPS);
#pragma unroll
                    for (int j = 0; j < 8; ++j) x[j] = isv ? x[j] : x[j] * rs * (isq ? qg[j] : kg[j]);
                }
                float y[8];
#pragma unroll
                for (int j = 0; j < 8; ++j) { const float p = __shfl_xor(x[j], 4); y[j] = (lat && !isv) ? fmaf(x[j], cs[j], sgn * p * sn[j]) : x[j]; }
                u32x4 o; o.x = pk2(y[0], y[1]); o.y = pk2(y[2], y[3]); o.z = pk2(y[4], y[5]); o.w = pk2(y[6], y[7]);
                if (isq) { *(u32x4*)(QB + (size_t)t * DM + 8 * c) = o; }
                else {
                    const int kvc = 8 * (c - 128 - (isv ? 32 : 0));
                    if (lat) { bf16_t* dst = (isv ? VALL : KALL) + ((size_t)bl * KV_LAT + PAST + tt) * KVW + kvc; *(u32x4*)dst = o; }
                    else { bf16_t* dst = (isv ? VC : KC) + (size_t)t * KVW + kvc; *(u32x4*)dst = o;
                        float* nd = (isv ? new_v : new_k) + (size_t)t * KVW + kvc;
                        *(f32x4*)nd = (f32x4){y[0], y[1], y[2], y[3]}; *(f32x4*)(nd + 4) = (f32x4){y[4], y[5], y[6], y[7]}; }
                }
            }
        }
    }
    SEAM(11);
    if (IN(12)) { PH_BEGIN();
        char* albs = (char*)lds_raw;
        const int xg = (int)blockIdx.x & 7, j = (int)blockIdx.x >> 3;
        const int n_lat = 512, n_all = 512 + 256;
        for (int it0 = 0; ; ++it0) {
            int it;
            if (F.G == 256) { if (it0 >= 3) break; it = (it0 < 2) ? ((2 * xg + it0) * 32 + j) : (512 + F.vcu); }
            else { it = (int)blockIdx.x + it0 * F.G; if (it >= n_all) break; }
            const bf16_t *qp, *kp, *vp; bf16_t* op; int seq;
            if (it < n_lat) { const int grp = it >> 5, jj = it & 31, b = grp >> 1, kvh = grp & 1, h = kvh * 4 + (jj >> 3), qb = jj & 7;
                const size_t qo = ((size_t)(T_CTX + b * SEQ_L + qb * 256)) * DM + h * HD, ko = (size_t)b * KV_LAT * KVW + kvh * HD;
                qp = QB + qo; op = OB + qo; kp = KALL + ko; vp = VALL + ko; seq = KV_LAT; }
            else { const int ic = it - n_lat, b = ic >> 3, h = ic & 7, kvh = h >> 2;
                const size_t qo = (size_t)(b * SEQ_C) * DM + h * HD, ko = (size_t)(b * SEQ_C) * KVW + kvh * HD;
                qp = QB + qo; op = OB + qo; kp = KC + ko; vp = VC + ko; seq = SEQ_C; }
            __syncthreads();
            att::attn_dense_body(qp, kp, vp, op, seq, albs, F.tid);
        }
        __syncthreads();
    }
    SEAM(12);
    if (IN(13)) { PH_BEGIN(); pg8::Gemm g{OB, Wo_t, T_ALL, DM, DM, DM, DM}; pg8::StaticOrder S; S.init(T_ALL, DM, F.G, (int)blockIdx.x, true); pg8::EpiBf16 E{XN, DM};
        pg8::gemm_phase<pg8::EpiBf16>(ring, xbuf, g, S, E, F.tid); }
    SEAM(13);
    if (IN(14)) { PH_BEGIN(); row_pass<1, false>(F, nullptr, nullptr, HB, nullptr, XN, XN, KIN(9) + DM, MOD + (size_t)9 * NMOD + 2 * DM, KIN(10) + DM, MOD + (size_t)9 * NMOD + 3 * DM, MOD + (size_t)9 * NMOD + 4 * DM); }
    SEAM(14);
    if (IN(15)) { PH_BEGIN(); FFN_UP(1); }
    SEAM(15);
    if (IN(17)) { PH_BEGIN(); FFN_DOWN(1); }
    SEAM(17);
    if (IN(18)) { PH_BEGIN(); row_pass<2, false>(F, nullptr, nullptr, HB, H, XN, nullptr, KIN(11) + DM, MOD + (size_t)9 * NMOD + 5 * DM, nullptr, nullptr, nullptr); }
    PROBE_END(18);
#undef IN
#undef SEAM
}

extern "C" void kernel_launch(void* const* d_in, const int* in_sizes, int n_in, void* d_out, int out_size, void* d_ws, size_t ws_size, hipStream_t stream) {
    static int grid = 0;
    if (grid == 0) {
        const long want_out = (long)T_ALL * DM + 2L * T_CTX * KVW;
        if (n_in != 22 || in_sizes[0] != T_CTX * DM || in_sizes[1] != T_LAT * DM || (long)out_size != want_out || ws_size < WS_END) {
            fprintf(stderr, "kernel_launch: shape mismatch (n_in %d out %d ws %zu)\n", n_in, out_size, ws_size); grid = -1; return; }
        int dev = 0, cus = 0;
        if (hipGetDevice(&dev) != hipSuccess || hipDeviceGetAttribute(&cus, hipDeviceAttributeMultiprocessorCount, dev) != hipSuccess) { grid = -1; return; }
        if (hipFuncSetAttribute((const void*)mega_fwd, hipFuncAttributeMaxDynamicSharedMemorySize, LDS_BYTES) != hipSuccess) { fprintf(stderr, "kernel_launch: hipFuncSetAttribute failed\n"); grid = -1; return; }
        int per_cu = 0;
        if (hipOccupancyMaxActiveBlocksPerMultiprocessor(&per_cu, (const void*)mega_fwd, 512, LDS_BYTES) != hipSuccess || per_cu < 1) fprintf(stderr, "kernel_launch: occupancy query says %d\n", per_cu);
        (void)hipGetLastError();
        grid = cus;
    }
    if (grid < 0) return;
    (void)hipMemsetAsync((char*)d_ws + WS_CTL, 0, CTL_ZERO_BYTES, stream);
    (void)hipMemsetAsync((char*)d_ws + WS_MOD, 0, (size_t)2 * 9 * NMOD * 4, stream);
    Args a{};
    for (int i = 0; i < 22; ++i) a.in[i] = (const float*)d_in[i];
    a.out = (float*)d_out; a.ws = (unsigned char*)d_ws;
#if MK_N_LAUNCHES == 1
    a.ph_lo = 0; a.ph_hi = N_PHASES;
    hipLaunchKernelGGL(mega_fwd, dim3(grid), dim3(512), LDS_BYTES, stream, a);
#else
    for (int p = 0; p < N_PHASES; ++p) { a.ph_lo = p; a.ph_hi = p + 1; hipLaunchKernelGGL(mega_fwd, dim3(grid), dim3(512), LDS_BYTES, stream, a); }
#endif
    const hipError_t le = hipPeekAtLastError();
    if (le != hipSuccess) fprintf(stderr, "kernel_launch: launch failed: %s\n", hipGetErrorName(le));
}
```

```cpp
#include <hip/hip_runtime.h>
#include <cstdio>
#include <cstdint>

#ifndef MK_N_LAUNCHES
#define MK_N_LAUNCHES 1
#endif
#define EPI_TWICE 0
#define PROBE_SUB 0
#define PROBE_MASK 0x0

#define GAS __attribute__((address_space(1)))
#define LAS __attribute__((address_space(3)))
typedef unsigned short bf16_t;
typedef short bf16x8 __attribute__((ext_vector_type(8)));
typedef short s16x4 __attribute__((ext_vector_type(4)));
typedef float f32x4 __attribute__((ext_vector_type(4)));
typedef float f32x2 __attribute__((ext_vector_type(2)));
typedef float f32x16 __attribute__((ext_vector_type(16)));
typedef unsigned u32x4 __attribute__((ext_vector_type(4)));
typedef unsigned u32x2 __attribute__((ext_vector_type(2)));

constexpr int DM = 1024, T_CTX = 8192, T_LAT = 16384, T_ALL = T_CTX + T_LAT, SEQ_C = 256, SEQ_L = 2048, PAST = 512, KV_LAT = PAST + SEQ_L;
constexpr int DFF = 2816, NUP = 2 * DFF, NQKV = 1536, NIN = 3072, NMOD = 6 * DM, HD = 128, NKVH = 2, NQH = 8, KVW = NKVH * HD;
constexpr float EPS = 1e-6f;

constexpr size_t MiB = 1u << 20;
constexpr size_t WS_CTL = 0, CTL_ZERO_BYTES = 64 * 1024;
constexpr size_t WS_MOD = 1 * MiB;
constexpr size_t WS_ROPE = 1 * MiB + 512 * 1024;
constexpr size_t WS_RAWB = 2 * MiB;
constexpr size_t WS_WIN = 8 * MiB, WS_WOUT = 14 * MiB, WS_WQKV = 16 * MiB, WS_WO = 19 * MiB, WS_WUP = 21 * MiB, WS_WDN = 43 * MiB;
constexpr size_t WS_XN = 54 * MiB;
constexpr size_t WS_BIG = 102 * MiB;
constexpr size_t WS_END = 250 * MiB;
constexpr size_t BIG_CV = 0;
constexpr size_t BIG_A2 = 0;
constexpr size_t BIG_QKV = 0, BIG_O = 0;
constexpr size_t BIG_Q = 72 * MiB, BIG_KALL = 120 * MiB, BIG_VALL = 130 * MiB, BIG_KC = 140 * MiB, BIG_VC = 144 * MiB;
constexpr int CW_BAR = 1024;

constexpr int RING_BYTES = 131072, XB_OFF = RING_BYTES, XB_BYTES = 8192, LDSCTL_OFF = XB_OFF + XB_BYTES, MISC_OFF = LDSCTL_OFF + 64, LDS_BYTES = 147456;

__device__ __forceinline__ unsigned f2bf(float f) { unsigned u = __builtin_bit_cast(unsigned, f); return (u + 0x7fffu + ((u >> 16) & 1u)) >> 16; }
__device__ __forceinline__ unsigned pk2(float lo, float hi) { return f2bf(lo) | (f2bf(hi) << 16); }
__device__ __forceinline__ float bflo(unsigned w) { return __builtin_bit_cast(float, w << 16); }
__device__ __forceinline__ float bfhi(unsigned w) { return __builtin_bit_cast(float, w & 0xffff0000u); }
__device__ __forceinline__ unsigned cvt_pk_bf16(float lo, float hi) { unsigned r; asm volatile("v_cvt_pk_bf16_f32 %0, %1, %2" : "=v"(r) : "v"(lo), "v"(hi)); return r; }
__device__ __forceinline__ float wave_sum(float v) {
#pragma unroll
    for (int o = 1; o < 64; o <<= 1) v += __shfl_xor(v, o);
    return v;
}
__device__ __forceinline__ float silu_f(float x) { const float e = __builtin_amdgcn_exp2f(-x * 1.4426950408889634f); return x * __builtin_amdgcn_rcpf(1.0f + e); }
#define LDS_WAIT() asm volatile("s_waitcnt lgkmcnt(0)" ::: "memory")
#define VM_WAIT() asm volatile("s_waitcnt vmcnt(0)" ::: "memory")

namespace pg8 {
constexpr int BM = 256, BK = 64, HALF = 128, HTB = HALF * BK * 2, STAGE_BYTES = 8 * HTB, NXCD = 8, WGM = 8;
__device__ __forceinline__ int lds_byte(int r, int c) { const int st = (r >> 4) * 2 + (c >> 5), rr = r & 15, cc = c & 31, ob = rr * 64 + cc * 2; return st * 1024 + (ob ^ (((ob >> 9) & 1) << 5)); }
__device__ __forceinline__ void stage_rc(int b, int& R, int& C) { const int st = b / 1024, sb = b % 1024, swz = sb ^ (((sb >> 9) & 1) << 5); R = (st >> 1) * 16 + swz / 64; C = (st & 1) * 32 + (swz % 64) / 2; }
__device__ __forceinline__ int perm32(int rho) { const int n = rho >> 4, i = rho & 15; return 8 * (i >> 2) + 4 * n + (i & 3); }

struct Unit { int pm, pn, half; };
struct Gemm { const bf16_t* A; const bf16_t* Bt; int M, N, K, lda, ldb; };

struct StaticOrder {
    int nM, nN, nwg, G, c, F, R; bool split;
    __device__ __forceinline__ void init(int M, int N, int G_, int c_, bool split_last = false) { nM = M / BM; nN = N / BM; nwg = nM * nN; G = G_; c = c_; F = nwg / G; R = nwg % G; split = split_last && R > 0 && 2 * R <= G; }
    __device__ __forceinline__ bool next(int i, Unit& u) const {
        long L;
        if (split && i >= F) { if (i > F || c >= 2 * R) return false; L = (long)F * G + (c >> 1); u.half = c & 1; }
        else { L = (long)i * G + c; if (L >= nwg) return false; u.half = -1; }
        int wgid = (int)L; { const int q = nwg / NXCD, r = nwg % NXCD, xcd = wgid % NXCD, off = wgid / NXCD; wgid = (xcd < r ? xcd * (q + 1) : r * (q + 1) + (xcd - r) * q) + off; }
        const int nig = WGM * nN, gid = wgid / nig, fm = gid * WGM, gsz = (nM - fm) < WGM ? (nM - fm) : WGM;
        u.pm = fm + ((wgid % nig) % gsz); u.pn = (wgid % nig) / gsz; return true;
    }
};

struct EpiBf16 {
    static constexpr bool PERM = true, ROWPERM = false;
    __device__ __forceinline__ static int nstores(const Unit& u) { return u.half < 0 ? 16 : 8; }
    bf16_t* O; int ldc;
    __device__ __forceinline__ void operator()(const f32x4 (&acc)[2][2][4][2], const Unit& u, int wr, int wc, int fr, int fq, LAS unsigned char*, int) const {
        const int row0 = u.pm * BM + (u.half > 0 ? HALF : 0) + wr * 64 + fr; const int col0 = u.pn * BM + wc * 32 + 8 * fq;
#pragma unroll
        for (int ai = 0; ai < 2; ++ai) if (ai == 0 || u.half < 0)
#pragma unroll
            for (int m = 0; m < 4; ++m) { bf16_t* rowp = O + (size_t)(row0 + ai * HALF + m * 16) * ldc + col0;
#pragma unroll
                for (int bj = 0; bj < 2; ++bj) { const f32x4 v0 = acc[ai][bj][m][0], v1 = acc[ai][bj][m][1];
                    u32x4 w; w.x = cvt_pk_bf16(v0[0], v0[1]); w.y = cvt_pk_bf16(v0[2], v0[3]); w.z = cvt_pk_bf16(v1[0], v1[1]); w.w = cvt_pk_bf16(v1[2], v1[3]);
                    *(u32x4*)(rowp + bj * HALF) = w; } }
    }
};

__device__ __forceinline__ float dpp_shr1(float x) { return __builtin_bit_cast(float, __builtin_amdgcn_update_dpp(0, __builtin_bit_cast(int, x), 0x111, 0xf, 0xf, true)); }
__device__ __forceinline__ float dpp_shl1(float x) { return __builtin_bit_cast(float, __builtin_amdgcn_update_dpp(0, __builtin_bit_cast(int, x), 0x101, 0xf, 0xf, true)); }
__device__ __forceinline__ float dpp_ror1(float x) { return __builtin_bit_cast(float, __builtin_amdgcn_update_dpp(0, __builtin_bit_cast(int, x), 0x121, 0xf, 0xf, true)); }
__device__ __forceinline__ float dpp_ror15(float x) { return __builtin_bit_cast(float, __builtin_amdgcn_update_dpp(0, __builtin_bit_cast(int, x), 0x12F, 0xf, 0xf, true)); }

struct EpiFfn {
    static constexpr bool PERM = true, ROWPERM = true;
    __device__ __forceinline__ static int nstores(const Unit&) { return 32; }
    bf16_t* A2; const float* cw; float* rawb;
    __device__ __forceinline__ void operator()(const f32x4 (&acc)[2][2][4][2], const Unit& u, int wr, int wc, int fr, int fq, LAS unsigned char* xb, int lane) const {
        (void)lane;
        const int ccol = wc * 32 + 8 * fq;
        const int f0 = u.pn * HALF + ccol;
        LAS float* XB = (LAS float*)xb;
        if (fr == 0) {
#pragma unroll
            for (int ai = 0; ai < 2; ++ai)
#pragma unroll
                for (int bj = 0; bj < 2; ++bj)
#pragma unroll
                    for (int n = 0; n < 2; ++n) *(LAS f32x4*)(XB + (ai * 4 + wr * 2 + 0) * 256 + bj * HALF + ccol + 4 * n) = acc[ai][bj][0][n];
        }
        if (fr == 15) {
#pragma unroll
            for (int ai = 0; ai < 2; ++ai)
#pragma unroll
                for (int bj = 0; bj < 2; ++bj)
#pragma unroll
                    for (int n = 0; n < 2; ++n) *(LAS f32x4*)(XB + (ai * 4 + wr * 2 + 1) * 256 + bj * HALF + ccol + 4 * n) = acc[ai][bj][3][n];
        }
        if (u.pm >= 32) {
            const int lt = u.pm - 32;
            if (wr == 0 && fr == 0) {
#pragma unroll
                for (int q = 0; q < 2; ++q)
#pragma unroll
                    for (int bj = 0; bj < 2; ++bj)
#pragma unroll
                        for (int n = 0; n < 2; ++n) *(f32x4*)(rawb + (size_t)(lt * 4 + q) * NUP + bj * DFF + f0 + 4 * n) = acc[0][bj][q][n];
            }
            if (wr == 1 && fr == 15) {
#pragma unroll
                for (int q = 2; q < 4; ++q)
#pragma unroll
                    for (int bj = 0; bj < 2; ++bj)
#pragma unroll
                        for (int n = 0; n < 2; ++n) *(f32x4*)(rawb + (size_t)(lt * 4 + q) * NUP + bj * DFF + f0 + 4 * n) = acc[1][bj][q][n];
            }
        }
        f32x4 w0[2][2], w1[2][2], w2[2][2];
#pragma unroll
        for (int n = 0; n < 2; ++n)
#pragma unroll
            for (int bj = 0; bj < 2; ++bj) { const float* p = cw + bj * DFF + f0 + 4 * n; w0[bj][n] = *(const f32x4*)p; w1[bj][n] = *(const f32x4*)(p + NUP); w2[bj][n] = *(const f32x4*)(p + 2 * NUP); }
        asm volatile("s_waitcnt lgkmcnt(0)" ::: "memory"); __builtin_amdgcn_s_barrier(); asm volatile("" ::: "memory");
        const float e0 = (fr == 0) ? 1.f : 0.f, e15 = (fr == 15) ? 1.f : 0.f;
#pragma unroll
        for (int n = 0; n < 2; ++n) {
#pragma unroll
            for (int ai = 0; ai < 2; ++ai) {
                const bool hasp = !(ai == 0 && wr == 0), hasn = !(ai == 1 && wr == 1);
                const int pslot = (wr == 1) ? (ai * 4 + 0 * 2 + 1) : (0 * 4 + 1 * 2 + 1);
                const int nslot = (wr == 0) ? (ai * 4 + 1 * 2 + 0) : (1 * 4 + 0 * 2 + 0);
                f32x4 cv[2][4];
#pragma unroll
                for (int bj = 0; bj < 2; ++bj) {
                    const f32x4 pe = hasp ? *(LAS f32x4*)(XB + pslot * 256 + bj * HALF + ccol + 4 * n) : (f32x4){0.f, 0.f, 0.f, 0.f};
                    const f32x4 ne = hasn ? *(LAS f32x4*)(XB + nslot * 256 + bj * HALF + ccol + 4 * n) : (f32x4){0.f, 0.f, 0.f, 0.f};
                    const f32x4 a0 = w0[bj][n], a1 = w1[bj][n], a2 = w2[bj][n];
                    const f32x4 x0 = acc[ai][bj][0][n], x1 = acc[ai][bj][1][n], x2 = acc[ai][bj][2][n], x3 = acc[ai][bj][3][n];
                    f32x4 c0 = a1 * x0 + a2 * x1 + (a0 * e0) * pe;
                    const f32x4 c1 = a0 * x0 + a1 * x1 + a2 * x2;
                    const f32x4 c2 = a0 * x1 + a1 * x2 + a2 * x3;
                    f32x4 c3 = a0 * x2 + a1 * x3 + (a2 * e15) * ne;
                    float c00 = c0[0], c01 = c0[1], c02 = c0[2], c03 = c0[3], c30 = c3[0], c31 = c3[1], c32 = c3[2], c33 = c3[3];
                    asm volatile(
                        "s_nop 1\n\t"
                        "v_fmac_f32_dpp %0, %8, %16 row_shr:1 row_mask:0xf bank_mask:0xf bound_ctrl:1\n\t"
                        "v_fmac_f32_dpp %1, %9, %17 row_shr:1 row_mask:0xf bank_mask:0xf bound_ctrl:1\n\t"
                        "v_fmac_f32_dpp %2, %10, %18 row_shr:1 row_mask:0xf bank_mask:0xf bound_ctrl:1\n\t"
                        "v_fmac_f32_dpp %3, %11, %19 row_shr:1 row_mask:0xf bank_mask:0xf bound_ctrl:1\n\t"
                        "v_fmac_f32_dpp %4, %12, %20 row_shl:1 row_mask:0xf bank_mask:0xf bound_ctrl:1\n\t"
                        "v_fmac_f32_dpp %5, %13, %21 row_shl:1 row_mask:0xf bank_mask:0xf bound_ctrl:1\n\t"
                        "v_fmac_f32_dpp %6, %14, %22 row_shl:1 row_mask:0xf bank_mask:0xf bound_ctrl:1\n\t"
                        "v_fmac_f32_dpp %7, %15, %23 row_shl:1 row_mask:0xf bank_mask:0xf bound_ctrl:1"
                        : "+v"(c00), "+v"(c01), "+v"(c02), "+v"(c03), "+v"(c30), "+v"(c31), "+v"(c32), "+v"(c33)
                        : "v"(x3[0]), "v"(x3[1]), "v"(x3[2]), "v"(x3[3]), "v"(x0[0]), "v"(x0[1]), "v"(x0[2]), "v"(x0[3]),
                          "v"(a0[0]), "v"(a0[1]), "v"(a0[2]), "v"(a0[3]), "v"(a2[0]), "v"(a2[1]), "v"(a2[2]), "v"(a2[3]));
                    cv[bj][0] = (f32x4){c00, c01, c02, c03}; cv[bj][1] = c1; cv[bj][2] = c2; cv[bj][3] = (f32x4){c30, c31, c32, c33};
                }
#pragma unroll
                for (int m = 0; m < 4; ++m) {
                    const f32x4 g = cv[0][m], t = g * (-1.4426950408889634f);
                    f32x4 d; d[0] = __builtin_amdgcn_exp2f(t[0]); d[1] = __builtin_amdgcn_exp2f(t[1]); d[2] = __builtin_amdgcn_exp2f(t[2]); d[3] = __builtin_amdgcn_exp2f(t[3]);
                    d = d + 1.0f;
                    f32x4 r; r[0] = __builtin_amdgcn_rcpf(d[0]); r[1] = __builtin_amdgcn_rcpf(d[1]); r[2] = __builtin_amdgcn_rcpf(d[2]); r[3] = __builtin_amdgcn_rcpf(d[3]);
                    const f32x4 a = (g * r) * cv[1][m];
                    u32x2 w; w.x = cvt_pk_bf16(a[0], a[1]); w.y = cvt_pk_bf16(a[2], a[3]);
                    const int row = u.pm * BM + ai * HALF + wr * 64 + 4 * fr + m;
                    *(u32x2*)(A2 + (size_t)row * DFF + f0 + 4 * n) = w;
                }
            }
        }
    }
};

template <class Epi, bool ALIGN_EPI = true, bool SP2 = true>
__device__ __forceinline__ void gemm_phase(LAS unsigned char* lds, LAS unsigned char* xb, const Gemm g, const StaticOrder& S, const Epi& E, const int tid) {
    const int wid = __builtin_amdgcn_readfirstlane(tid >> 6), lane = tid & 63, wr = wid >> 2, wc = wid & 3, fr = lane & 15, fq = lane >> 4;
    const int K = g.K, nt = K / BK;
    unsigned voffA[2], voffB[2];
#pragma unroll
    for (int i = 0; i < 2; ++i) { int R, C; stage_rc(tid * 16 + i * 8192, R, C); const int Rb = Epi::PERM ? ((R & ~31) + perm32(R & 31)) : R;
        const int Ra = Epi::ROWPERM ? ((R & ~63) + 4 * (R & 15) + ((R >> 4) & 3)) : R;
        voffA[i] = (unsigned)(Ra * g.lda + C) * 2u; voffB[i] = (unsigned)(Rb * g.ldb + C) * 2u; }
    const size_t kstep = (size_t)(BK * 2);
    const size_t hstepA = (size_t)HALF * g.lda * 2, hstepB = (size_t)HALF * g.ldb * 2;
    const size_t tstepA = 2 * hstepA, tstepB = 2 * hstepB;
    const unsigned ldsw = (unsigned)wid * 1024u;
    const int aoff = lds_byte(wr * 64 + fr, fq * 8), boff = lds_byte(wc * 32 + fr, fq * 8);
#define PG8_SA(b, h) (((b) * 2 + (h)) * HTB)
#define PG8_SB(b, h) ((4 + (b) * 2 + (h)) * HTB)
#define PG8_STAGE(bufoff, gbase, voff) do { _Pragma("unroll") for (int _i = 0; _i < 2; ++_i) \
        __builtin_amdgcn_global_load_lds((const unsigned*)((const char*)(gbase) + (voff)[_i]), (LAS unsigned*)(lds + (bufoff) + ldsw + _i * 8192), 16, 0, 0); } while (0)
#define PG8_LDA(dst, b, h) do { _Pragma("unroll") for (int m = 0; m < 4; ++m) _Pragma("unroll") for (int k = 0; k < 2; ++k) dst[m][k] = *(const LAS bf16x8*)(lds + PG8_SA(b, h) + aoff + m * 2048 + k * 1024); } while (0)
#define PG8_LDB(dst, b, h) do { _Pragma("unroll") for (int n = 0; n < 2; ++n) _Pragma("unroll") for (int k = 0; k < 2; ++k) dst[n][k] = *(const LAS bf16x8*)(lds + PG8_SB(b, h) + boff + n * 2048 + k * 1024); } while (0)
#define PG8_MMA(ai, bj, At, Bt) do { __builtin_amdgcn_s_setprio(1); _Pragma("unroll") for (int m = 0; m < 4; ++m) _Pragma("unroll") for (int n = 0; n < 2; ++n) _Pragma("unroll") for (int k = 0; k < 2; ++k) \
        acc[ai][bj][m][n] = __builtin_amdgcn_mfma_f32_16x16x32_bf16(Bt[n][k], At[m][k], acc[ai][bj][m][n], 0, 0, 0); __builtin_amdgcn_s_setprio(0); } while (0)
#define PG8_WAIT_V(n) asm volatile("s_waitcnt vmcnt(" #n ")" ::: "memory")
#define PG8_WAIT_L(n) asm volatile("s_waitcnt lgkmcnt(" #n ")" ::: "memory")
#define PG8_BAR __builtin_amdgcn_s_barrier()
#define PG8_SCHED __builtin_amdgcn_sched_barrier(0)
    Unit cur, nxt; int ui = 0, relax = 0;
    if (!S.next(0, cur)) return;
    f32x4 acc[2][2][4][2];
#pragma unroll
    for (int a = 0; a < 2; ++a)
#pragma unroll
        for (int b = 0; b < 2; ++b)
#pragma unroll
            for (int m = 0; m < 4; ++m)
#pragma unroll
                for (int n = 0; n < 2; ++n) acc[a][b][m][n] = (f32x4){0.f, 0.f, 0.f, 0.f};
    bf16x8 At[4][2], B0[2][2], B1[2][2];
    const char* cA = (const char*)g.A + (size_t)cur.pm * tstepA + (cur.half > 0 ? hstepA : 0); const char* cB = (const char*)g.Bt + (size_t)cur.pn * tstepB;
    size_t chs = (cur.half < 0) ? hstepA : 0;
    if constexpr (SP2) {
        PG8_STAGE(PG8_SB(0, 0), cB, voffB); PG8_STAGE(PG8_SB(0, 1), cB + hstepB, voffB); PG8_STAGE(PG8_SA(0, 0), cA, voffA); PG8_STAGE(PG8_SA(0, 1), cA + chs, voffA);
        if (wr == 1) PG8_BAR;
        PG8_WAIT_V(2); PG8_BAR;
        PG8_STAGE(PG8_SB(1, 0), cB + kstep, voffB); PG8_STAGE(PG8_SA(1, 0), cA + kstep, voffA); PG8_STAGE(PG8_SB(1, 1), cB + hstepB + kstep, voffB);
        PG8_WAIT_V(6); PG8_BAR;
    } else {
        PG8_STAGE(PG8_SB(0, 0), cB, voffB); PG8_STAGE(PG8_SA(0, 0), cA, voffA); PG8_STAGE(PG8_SB(0, 1), cB + hstepB, voffB); PG8_STAGE(PG8_SA(0, 1), cA + chs, voffA);
        if (wr == 1) PG8_BAR;
        PG8_WAIT_V(4); PG8_BAR;
        PG8_STAGE(PG8_SB(1, 0), cB + kstep, voffB); PG8_STAGE(PG8_SA(1, 0), cA + kstep, voffA); PG8_STAGE(PG8_SB(1, 1), cB + hstepB + kstep, voffB);
        PG8_WAIT_V(6); PG8_BAR;
    }
    for (;;) {
        const bool has_next = S.next(ui + 1, nxt);
        const char* nA = has_next ? (const char*)g.A + (size_t)nxt.pm * tstepA + (nxt.half > 0 ? hstepA : 0) : cA; const char* nB = has_next ? (const char*)g.Bt + (size_t)nxt.pn * tstepB : cB;
        const size_t nhs = has_next ? ((nxt.half < 0) ? hstepA : 0) : chs;
        const bool full = cur.half < 0;
        for (int t = 0; t < nt; t += 2) {
            const bool last = (t == nt - 2);
            const char* a1 = cA + (size_t)(t + 1) * kstep;
            const char* a2 = last ? nA : cA + (size_t)(t + 2) * kstep; const char* b2 = last ? nB : cB + (size_t)(t + 2) * kstep;
            const char* a3 = a2 + kstep; const char* b3 = b2 + kstep;
            const size_t h2 = last ? nhs : chs;
            if constexpr (SP2) {
            int rel = __builtin_amdgcn_readfirstlane(relax); asm volatile("" : "+s"(rel));
#define PG8_WAIT_V8R() asm volatile("s_cmp_lt_i32 %0, 16\n\ts_cbranch_scc1 1f\n\ts_waitcnt vmcnt(24)\n\ts_branch 2f\n1:\n\ts_waitcnt vmcnt(8)\n2:" :: "s"(rel) : "memory", "scc")
            PG8_LDB(B0, 0, 0); PG8_LDB(B1, 0, 1); PG8_SCHED; PG8_LDA(At, 0, 0); PG8_STAGE(PG8_SA(1, 1), a1 + chs, voffA);
            PG8_WAIT_V8R(); PG8_WAIT_L(0); PG8_BAR; PG8_MMA(0, 0, At, B0); PG8_MMA(0, 1, At, B1); PG8_BAR; PG8_SCHED;
            if (full) PG8_LDA(At, 0, 1); PG8_STAGE(PG8_SB(0, 0), b2, voffB); PG8_STAGE(PG8_SB(0, 1), b2 + hstepB, voffB); PG8_STAGE(PG8_SA(0, 0), a2, voffA);
            PG8_WAIT_V8R(); PG8_WAIT_L(0); PG8_BAR; if (full) { PG8_MMA(1, 0, At, B0); PG8_MMA(1, 1, At, B1); } PG8_BAR; PG8_SCHED;
#undef PG8_WAIT_V8R
            PG8_LDB(B0, 1, 0); PG8_LDB(B1, 1, 1); PG8_SCHED; PG8_LDA(At, 1, 0); PG8_STAGE(PG8_SA(0, 1), a2 + h2, voffA);
            PG8_WAIT_V(8); PG8_WAIT_L(0); PG8_BAR; PG8_MMA(0, 0, At, B0); PG8_MMA(0, 1, At, B1); PG8_BAR; PG8_SCHED;
            if (full) PG8_LDA(At, 1, 1); PG8_STAGE(PG8_SB(1, 0), b3, voffB); PG8_STAGE(PG8_SB(1, 1), b3 + hstepB, voffB); PG8_STAGE(PG8_SA(1, 0), a3, voffA);
            PG8_WAIT_V(8); PG8_WAIT_L(0); PG8_BAR; if (full) { PG8_MMA(1, 0, At, B0); PG8_MMA(1, 1, At, B1); } PG8_BAR; PG8_SCHED;
            relax = 0; asm volatile("" : "+s"(relax));
            } else {
            static_assert(SP2, "the four-phase loop has no half-unit support");
            PG8_LDB(B0, 0, 0); PG8_SCHED; PG8_LDA(At, 0, 0); PG8_STAGE(PG8_SA(1, 1), a1 + hstepA, voffA);
            PG8_WAIT_L(8); PG8_BAR; PG8_WAIT_L(0); PG8_MMA(0, 0, At, B0); PG8_BAR; PG8_SCHED;
            PG8_LDB(B1, 0, 1); PG8_STAGE(PG8_SB(0, 0), b2, voffB);
            PG8_BAR; PG8_WAIT_L(0); PG8_MMA(0, 1, At, B1); PG8_BAR;
            PG8_LDA(At, 0, 1); PG8_STAGE(PG8_SA(0, 0), a2, voffA);
            PG8_BAR; PG8_WAIT_L(0); PG8_MMA(1, 0, At, B0); PG8_BAR; PG8_SCHED;
            PG8_STAGE(PG8_SB(0, 1), b2 + hstepB, voffB);
            PG8_WAIT_V(6); PG8_BAR; PG8_MMA(1, 1, At, B1); PG8_BAR;
            PG8_LDB(B0, 1, 0); PG8_SCHED; PG8_LDA(At, 1, 0); PG8_STAGE(PG8_SA(0, 1), a2 + hstepA, voffA);
            PG8_WAIT_L(8); PG8_BAR; PG8_WAIT_L(0); PG8_MMA(0, 0, At, B0); PG8_BAR; PG8_SCHED;
            PG8_LDB(B1, 1, 1); PG8_STAGE(PG8_SB(1, 0), b3, voffB);
            PG8_BAR; PG8_WAIT_L(0); PG8_MMA(0, 1, At, B1); PG8_BAR;
            PG8_LDA(At, 1, 1); PG8_STAGE(PG8_SA(1, 0), a3, voffA);
            PG8_BAR; PG8_WAIT_L(0); PG8_MMA(1, 0, At, B0); PG8_BAR; PG8_SCHED;
            PG8_STAGE(PG8_SB(1, 1), b3 + hstepB, voffB);
            PG8_WAIT_V(6); PG8_BAR; PG8_MMA(1, 1, At, B1); PG8_BAR;
            }
        }
        if constexpr (ALIGN_EPI) { if (wr == 0) PG8_BAR; }
        E(acc, cur, wr, wc, fr, fq, xb, lane);
#if EPI_TWICE
        asm volatile("" ::: "memory"); E(acc, cur, wr, wc, fr, fq, xb, lane);
#endif
        if (!has_next) break;
#pragma unroll
        for (int a = 0; a < 2; ++a)
#pragma unroll
            for (int b = 0; b < 2; ++b)
#pragma unroll
                for (int m = 0; m < 4; ++m)
#pragma unroll
                    for (int n = 0; n < 2; ++n) acc[a][b][m][n] = (f32x4){0.f, 0.f, 0.f, 0.f};
        relax = Epi::nstores(cur);
        cur = nxt; cA = nA; cB = nB; chs = nhs; ++ui;
        if constexpr (ALIGN_EPI) { if (wr == 1) PG8_BAR; }
    }
    PG8_WAIT_V(0);
    if constexpr (!ALIGN_EPI) { if (wr == 0) PG8_BAR; }
    PG8_BAR;
#undef PG8_SA
#undef PG8_SB
#undef PG8_STAGE
#undef PG8_LDA
#undef PG8_LDB
#undef PG8_MMA
#undef PG8_WAIT_V
#undef PG8_WAIT_L
#undef PG8_BAR
#undef PG8_SCHED
}
}

namespace att {
constexpr int D = 128, NW = 8, QBLK = 32, KVBLK = 64;
constexpr float SCALE = 0.088388347648318440f;
constexpr float THR = 8.f;
constexpr int LDQ = DM, LDK = KVW, LDO = DM;
constexpr size_t SHM_V = KVBLK * D * 2, SHM_K = KVBLK * D * 2, SHM_ATTN = 2 * SHM_V + 2 * SHM_K + NW * 64 * 4;
#define KSWZ(row, colB) ((row) * 256 + ((colB) ^ (((row) & 7) << 4)))
#define SBAR() __builtin_amdgcn_sched_barrier(0)
__device__ __forceinline__ int crow(int r, int hi) { return (r & 3) + 8 * (r >> 2) + 4 * hi; }
__device__ __forceinline__ unsigned cvtpk(float lo, float hi) { unsigned r; asm volatile("v_cvt_pk_bf16_f32 %0, %1, %2" : "=v"(r) : "v"(lo), "v"(hi)); return r; }
__device__ __forceinline__ bf16x8 ld8(const bf16_t* p) { return *reinterpret_cast<const bf16x8*>(p); }

__device__ __forceinline__ void partialSM(f32x16& p0, f32x16& p1, float& m_reg, float& mn, float& alpha) {
  constexpr float C = SCALE * 1.4426950408889634f;
  float pmax = p0[0];
#pragma unroll
  for (int r = 1; r < 16; ++r) pmax = fmaxf(pmax, p0[r]);
#pragma unroll
  for (int r = 0; r < 16; ++r) pmax = fmaxf(pmax, p1[r]);
  { auto rr = __builtin_amdgcn_permlane32_swap(__float_as_uint(pmax), __float_as_uint(pmax), false, false);
    pmax = fmaxf(__uint_as_float(rr[0]), __uint_as_float(rr[1])); }
  if (__builtin_expect(__all(pmax - m_reg <= THR / SCALE), 1)) { mn = m_reg; alpha = 1.f; }
  else { mn = fmaxf(m_reg, pmax); alpha = __builtin_amdgcn_exp2f((m_reg - mn) * C); m_reg = mn; }
  float mnC = -mn * C;
#pragma unroll
  for (int r = 0; r < 16; ++r) p0[r] = fmaf(p0[r], C, mnC);
#pragma unroll
  for (int r = 0; r < 16; ++r) p1[r] = fmaf(p1[r], C, mnC);
#pragma unroll
  for (int r = 0; r < 16; ++r) p0[r] = __builtin_amdgcn_exp2f(p0[r]);
}
__device__ __forceinline__ void finishSM(f32x16& p0, f32x16& p1, float alpha, float& l_reg, bf16x8& pa0, bf16x8& pa1, bf16x8& pa2, bf16x8& pa3) {
#pragma unroll
  for (int r = 0; r < 16; ++r) p1[r] = __builtin_amdgcn_exp2f(p1[r]);
  float ps = 0;
#pragma unroll
  for (int r = 0; r < 16; ++r) ps += p0[r];
#pragma unroll
  for (int r = 0; r < 16; ++r) ps += p1[r];
  { auto rr = __builtin_amdgcn_permlane32_swap(__float_as_uint(ps), __float_as_uint(ps), false, false);
    ps = __uint_as_float(rr[0]) + __uint_as_float(rr[1]); }
  l_reg = l_reg * alpha + ps;
#define PK4(P, BASE, OUT) do { unsigned a0 = cvtpk(P[BASE + 0], P[BASE + 1]), a1 = cvtpk(P[BASE + 2], P[BASE + 3]);   \
    unsigned b0 = cvtpk(P[BASE + 4], P[BASE + 5]), b1 = cvtpk(P[BASE + 6], P[BASE + 7]);                              \
    auto r0 = __builtin_amdgcn_permlane32_swap(a0, b0, false, false); auto r1 = __builtin_amdgcn_permlane32_swap(a1, b1, false, false); \
    u32x4 w = {r0[0], r1[0], r0[1], r1[1]}; OUT = *reinterpret_cast<bf16x8*>(&w); } while (0)
  PK4(p0, 0, pa0); PK4(p0, 8, pa1); PK4(p1, 0, pa2); PK4(p1, 8, pa3);
#undef PK4
}
__device__ __forceinline__ void qkt(f32x16& p0, f32x16& p1, const bf16_t* Ks, const bf16x8* qr, int r32, int hi) {
  p0 = f32x16{}; p1 = f32x16{};
#pragma unroll
  for (int d0 = 0; d0 < 8; ++d0) { int cb = (d0 * 16 + hi * 8) * 2;
    bf16x8 b0 = *reinterpret_cast<const bf16x8*>((const char*)Ks + KSWZ(r32, cb));
    bf16x8 b1 = *reinterpret_cast<const bf16x8*>((const char*)Ks + KSWZ(32 + r32, cb));
    p0 = __builtin_amdgcn_mfma_f32_32x32x16_bf16(b0, qr[d0], p0, 0, 0, 0);
    p1 = __builtin_amdgcn_mfma_f32_32x32x16_bf16(b1, qr[d0], p1, 0, 0, 0); }
}
__device__ __forceinline__ int v_st(int k, int c) { const int kk = (k & ~0xC) | ((k & 4) << 1) | ((k & 8) >> 1); return ((kk >> 3) * 4 + (c >> 5)) * 512 + ((kk & 7) * 32 + (c & 31)) * 2; }
__device__ __forceinline__ int v_rd_base(int lane) { return ((lane & 3) << 3) | (((lane >> 2) & 3) << 6) | (((lane >> 4) & 1) << 5) | (((lane >> 5) & 1) << 8); }
constexpr int v_rd_off(int d0, int ks, int half) { return d0 * 512 + ks * 4096 + half * 2048; }
template <int OFF> __device__ __forceinline__ s16x4 tr_read(int vb) {
  s16x4 r; asm volatile("ds_read_b64_tr_b16 %0, %1 offset:%2" : "=&v"(r) : "v"(vb), "i"(OFF) : "memory"); return r;
}
template <int D0> __device__ __forceinline__ void pv_one(f32x16& od, int vb, bf16x8 pa0, bf16x8 pa1, bf16x8 pa2, bf16x8 pa3) {
  const s16x4 l0 = tr_read<v_rd_off(D0, 0, 0)>(vb), h0 = tr_read<v_rd_off(D0, 0, 1)>(vb), l1 = tr_read<v_rd_off(D0, 1, 0)>(vb), h1 = tr_read<v_rd_off(D0, 1, 1)>(vb);
  const s16x4 l2 = tr_read<v_rd_off(D0, 2, 0)>(vb), h2 = tr_read<v_rd_off(D0, 2, 1)>(vb), l3 = tr_read<v_rd_off(D0, 3, 0)>(vb), h3 = tr_read<v_rd_off(D0, 3, 1)>(vb);
  asm volatile("s_waitcnt lgkmcnt(0)" ::: "memory"); SBAR();
#define PK(L, H) (bf16x8){L[0], L[1], L[2], L[3], H[0], H[1], H[2], H[3]}
  od = __builtin_amdgcn_mfma_f32_32x32x16_bf16(pa0, PK(l0, h0), od, 0, 0, 0);
  od = __builtin_amdgcn_mfma_f32_32x32x16_bf16(pa1, PK(l1, h1), od, 0, 0, 0);
  od = __builtin_amdgcn_mfma_f32_32x32x16_bf16(pa2, PK(l2, h2), od, 0, 0, 0);
  od = __builtin_amdgcn_mfma_f32_32x32x16_bf16(pa3, PK(l3, h3), od, 0, 0, 0);
#undef PK
}
__device__ __forceinline__ void pv_d0(f32x16* o, int vb, bf16x8 pa0, bf16x8 pa1, bf16x8 pa2, bf16x8 pa3) {
  pv_one<0>(o[0], vb, pa0, pa1, pa2, pa3); pv_one<1>(o[1], vb, pa0, pa1, pa2, pa3); pv_one<2>(o[2], vb, pa0, pa1, pa2, pa3); pv_one<3>(o[3], vb, pa0, pa1, pa2, pa3);
}

__device__ __forceinline__ void attn_dense_body(const bf16_t* __restrict__ Qb, const bf16_t* __restrict__ Kh, const bf16_t* __restrict__ Vh,
                                                bf16_t* __restrict__ Ob, int seq, char* lds, const int tid) {
  const int wid = tid >> 6, lane = tid & 63, r32 = lane & 31, hi = lane >> 5;
  bf16_t* V_lds = (bf16_t*)lds; bf16_t* K_lds = (bf16_t*)(lds + 2 * SHM_V);
  float* ws = (float*)(lds + 2 * SHM_V + 2 * SHM_K) + wid * 64; float* li_l = ws; float* al_l = ws + 32;
  float m_reg = -1e30f, l_reg = 0; f32x16 o[4] = {}; bf16x8 qr[8];
  const bf16_t* Qw = Qb + (long)(wid * QBLK + r32) * LDQ + hi * 8;
#pragma unroll
  for (int d0 = 0; d0 < 8; ++d0) qr[d0] = ld8(Qw + d0 * 16);
  const int sr = tid >> 4, sc = (tid & 15) * 8, vst0 = v_st(sr, sc), vst1 = v_st(32 + sr, sc);
  const int vb0 = (int)(uintptr_t)V_lds + v_rd_base(lane);
  struct { bf16x8 vs0, vs1, ks0, ks1; } sr_[2];
#define SLOAD(i, k0) do { sr_[i].vs0 = ld8(&Vh[(long)((k0) + sr) * LDK + sc]); sr_[i].vs1 = ld8(&Vh[(long)((k0) + 32 + sr) * LDK + sc]); \
    sr_[i].ks0 = ld8(&Kh[(long)((k0) + sr) * LDK + sc]); sr_[i].ks1 = ld8(&Kh[(long)((k0) + 32 + sr) * LDK + sc]); } while (0)
#define SWRITE(b, i) do { *(bf16x8*)((char*)V_lds + (b) * SHM_V + vst0) = sr_[i].vs0;          \
    *(bf16x8*)((char*)V_lds + (b) * SHM_V + vst1) = sr_[i].vs1; int kc = sc * 2;               \
    *(bf16x8*)((char*)K_lds + (b) * SHM_K + KSWZ(sr, kc)) = sr_[i].ks0;                       \
    *(bf16x8*)((char*)K_lds + (b) * SHM_K + KSWZ(32 + sr, kc)) = sr_[i].ks1; } while (0)
#define SWAIT() asm volatile("s_waitcnt vmcnt(4)" ::: "memory")
#define RESC(a) do { if (__any((a) < 1.f)) { if (hi == 0) al_l[r32] = (a); asm volatile("s_waitcnt lgkmcnt(0)" ::: "memory"); \
    _Pragma("unroll") for (int d = 0; d < 4; ++d) _Pragma("unroll") for (int r = 0; r < 16; ++r) o[d][r] *= al_l[crow(r, hi)]; } } while (0)
  f32x16 pA0, pA1, pB0, pB1; float mnA, mnB, alA, alB; bf16x8 pa0, pa1, pa2, pa3; const int NT = seq / KVBLK;
  constexpr int SE = 0, SO = 1;
  SLOAD(SE, 0); asm volatile("s_waitcnt vmcnt(0)" ::: "memory"); SWRITE(0, SE); __syncthreads();
  qkt(pA0, pA1, K_lds, qr, r32, hi); partialSM(pA0, pA1, m_reg, mnA, alA);
  SLOAD(SO, KVBLK); if (2 < NT) SLOAD(SE, 2 * KVBLK);
  SWAIT(); SWRITE(1, SO); __syncthreads();
  for (int j = 1; j + 1 < NT; j += 2) {
    SBAR(); qkt(pB0, pB1, (bf16_t*)((char*)K_lds + SHM_K), qr, r32, hi);
    finishSM(pA0, pA1, alA, l_reg, pa0, pa1, pa2, pa3); SBAR();
    SLOAD(SO, (j + 2) * KVBLK); SBAR();
    pv_d0(o, vb0, pa0, pa1, pa2, pa3); partialSM(pB0, pB1, m_reg, mnB, alB);
    __syncthreads(); SWAIT(); SWRITE(0, SE);
    RESC(alB); __syncthreads();
    SBAR(); qkt(pA0, pA1, K_lds, qr, r32, hi);
    finishSM(pB0, pB1, alB, l_reg, pa0, pa1, pa2, pa3); SBAR();
    if (j + 3 < NT) SLOAD(SE, (j + 3) * KVBLK); SBAR();
    pv_d0(o, vb0 + (int)SHM_V, pa0, pa1, pa2, pa3); partialSM(pA0, pA1, m_reg, mnA, alA);
    __syncthreads(); SWAIT(); SWRITE(1, SO);
    RESC(alA); __syncthreads();
  }
  SBAR(); qkt(pB0, pB1, (bf16_t*)((char*)K_lds + SHM_K), qr, r32, hi);
  finishSM(pA0, pA1, alA, l_reg, pa0, pa1, pa2, pa3); SBAR();
  pv_d0(o, vb0, pa0, pa1, pa2, pa3); partialSM(pB0, pB1, m_reg, mnB, alB);
  __syncthreads(); RESC(alB);
  finishSM(pB0, pB1, alB, l_reg, pa0, pa1, pa2, pa3); SBAR();
  pv_d0(o, vb0 + (int)SHM_V, pa0, pa1, pa2, pa3);
  if (hi == 0) li_l[r32] = l_reg; asm volatile("s_waitcnt lgkmcnt(0)" ::: "memory");
  float rli[16];
#pragma unroll
  for (int r = 0; r < 16; ++r) rli[r] = __builtin_amdgcn_rcpf(li_l[crow(r, hi)]);
  bf16_t* Ow = Ob + (long)(wid * QBLK) * LDO;
#pragma unroll
  for (int r = 0; r < 16; ++r) { int orow = crow(r, hi);
#pragma unroll
    for (int d0 = 0; d0 < 4; ++d0) Ow[(long)orow * LDO + d0 * 32 + r32] = (bf16_t)f2bf(o[d0][r] * rli[r]); }
#undef SLOAD
#undef SWRITE
#undef SWAIT
#undef RESC
}
#undef KSWZ
#undef SBAR
}

#define XB_TMO      128
#define XB_XCNT(j)  (256  + 64 * (j))
#define XB_XSUB(j)  (1280 + 64 * (j))
#define XB_XGEN(j)  (2304 + 64 * (j))
#define XB_TOP      3328
#define XB_TOPGEN   3392
#define XCD_BAR_WORDS 3456
#define XB_SPIN_CAP (1u << 18)
__device__ __forceinline__ unsigned xb_ld(unsigned* p)              { return __hip_atomic_load(p, __ATOMIC_RELAXED, __HIP_MEMORY_SCOPE_AGENT); }
__device__ __forceinline__ unsigned xb_add(unsigned* p, unsigned v) { return __hip_atomic_fetch_add(p, v, __ATOMIC_RELAXED, __HIP_MEMORY_SCOPE_AGENT); }
__device__ __forceinline__ unsigned xb_xcc_id() { return (unsigned)__builtin_amdgcn_s_getreg((3 << 11) | 20) & 0xFu; }
#define XB_SPIN(cond, bar) do { unsigned _sp = 0; while (cond) { __builtin_amdgcn_s_sleep(1); \
    if ((++_sp & 255u) == 0u) { if (xb_ld(&(bar)[XB_TMO])) break; if (_sp > XB_SPIN_CAP) { atomicAdd(&(bar)[XB_TMO], 1u); break; } } } } while (0)
struct XcdBarrier { unsigned* bar; unsigned x; volatile LAS unsigned* st; };
__device__ __forceinline__ XcdBarrier xcd_barrier_post(unsigned* bar, volatile LAS unsigned* st) {
    XcdBarrier b; b.bar = bar; b.x = xb_xcc_id(); b.st = st;
    if (threadIdx.x == 0) (void)xb_add(&bar[XB_XCNT(b.x)], 1u);
    return b;
}
__device__ __forceinline__ void xcd_barrier_complete(unsigned* bar, unsigned x, unsigned& nloc, unsigned& nx) {
    const unsigned G = gridDim.x * gridDim.y * gridDim.z;
    unsigned sum, cnt, mine, sp = 0u;
    for (;;) {
        sum = 0u; cnt = 0u; mine = 0u;
#pragma unroll
        for (unsigned j = 0; j < 16; ++j) { const unsigned c = xb_ld(&bar[XB_XCNT(j)]); sum += c; cnt += (c > 0u) ? 1u : 0u; mine = (j == x) ? c : mine; }
        if (sum == G) break;
        __builtin_amdgcn_s_sleep(1);
        if ((++sp & 255u) == 0u) { if (xb_ld(&bar[XB_TMO])) break; if (sp > XB_SPIN_CAP) { atomicAdd(&bar[XB_TMO], 1u); break; } }
    }
    nloc = mine > 0u ? mine : 1u; nx = cnt > 0u ? cnt : 1u;
}
__device__ __forceinline__ void xcd_barrier(const XcdBarrier& b) {
    asm volatile("s_waitcnt vmcnt(0)" ::: "memory");
    __syncthreads();
    if (threadIdx.x == 0) {
        unsigned* bar = b.bar;
        __builtin_amdgcn_s_waitcnt(0);
        unsigned nloc = b.st[0], nx = b.st[1];
        if (nloc == 0u) { xcd_barrier_complete(bar, b.x, nloc, nx); b.st[0] = nloc; b.st[1] = nx; }
        const unsigned old = xb_add(&bar[XB_XSUB(b.x)], 1u);
        const unsigned gen = old / nloc;
        if (old + 1u == (gen + 1u) * nloc) {
            __builtin_amdgcn_fence(__ATOMIC_RELEASE, "agent");
            asm volatile("s_waitcnt vmcnt(0)" ::: "memory");
            const unsigned og = xb_add(&bar[XB_TOP], 1u);
            const unsigned tg = og / nx;
            if (og + 1u == (tg + 1u) * nx) xb_add(&bar[XB_TOPGEN], 1u);
            else XB_SPIN(xb_ld(&bar[XB_TOPGEN]) == tg, bar);
            __builtin_amdgcn_fence(__ATOMIC_ACQUIRE, "agent");
            xb_add(&bar[XB_XGEN(b.x)], 1u);
            asm volatile("s_waitcnt vmcnt(0)" ::: "memory");
        } else {
            XB_SPIN(xb_ld(&bar[XB_XGEN(b.x)]) == gen, bar);
            __builtin_amdgcn_fence(__ATOMIC_ACQUIRE, "agent");
            asm volatile("s_waitcnt vmcnt(0)" ::: "memory");
        }
    }
    __syncthreads();
}

struct Args {
    const float* in[22]; float* out; unsigned char* ws; int ph_lo, ph_hi;
};
struct Frame {
    LAS unsigned char* lds; unsigned char* ws;
    int tid, lane, wave, vcu, G;
};

struct TrItem { const float* W; bf16_t* WT; int N, ldk, dest_row0, k0, n0; };
__device__ __forceinline__ void tr_load(const TrItem& t, f32x4 (&v)[8], int lane) {
    const int r = lane >> 3, c4 = lane & 7;
#pragma unroll
    for (int i = 0; i < 8; ++i) v[i] = *(const f32x4*)(t.W + (size_t)(t.k0 + 8 * i + r) * t.N + t.n0 + 4 * c4);
}
__device__ __forceinline__ void tr_finish(const TrItem& t, const f32x4 (&v)[8], LAS float* scr, int lane) {
    const int r = lane >> 3, c4 = lane & 7;
#pragma unroll
    for (int i = 0; i < 8; ++i)
#pragma unroll
        for (int q = 0; q < 4; ++q) scr[(4 * c4 + q) * 65 + 8 * i + r] = v[i][q];
    LDS_WAIT(); asm volatile("" ::: "memory");
    const int c = lane & 7;
#pragma unroll
    for (int j = 0; j < 4; ++j) { const int n = (lane >> 3) + 8 * j; const LAS float* s = scr + n * 65 + 8 * c;
        u32x4 o; o.x = pk2(s[0], s[1]); o.y = pk2(s[2], s[3]); o.z = pk2(s[4], s[5]); o.w = pk2(s[6], s[7]);
        *(u32x4*)(t.WT + (size_t)(t.dest_row0 + n) * t.ldk + t.k0 + 8 * c) = o; }
    LDS_WAIT(); asm volatile("" ::: "memory");
}

__device__ __forceinline__ void load16(const float* p, int lane, float (&v)[16]) {
    const f32x4 a = *(const f32x4*)(p + 8 * lane), b = *(const f32x4*)(p + 8 * lane + 4), c = *(const f32x4*)(p + 512 + 8 * lane), d = *(const f32x4*)(p + 512 + 8 * lane + 4);
#pragma unroll
    for (int j = 0; j < 4; ++j) { v[j] = a[j]; v[4 + j] = b[j]; v[8 + j] = c[j]; v[12 + j] = d[j]; }
}
__device__ __forceinline__ void store16f(float* p, int lane, const float (&v)[16]) {
    *(f32x4*)(p + 8 * lane) = (f32x4){v[0], v[1], v[2], v[3]}; *(f32x4*)(p + 8 * lane + 4) = (f32x4){v[4], v[5], v[6], v[7]};
    *(f32x4*)(p + 512 + 8 * lane) = (f32x4){v[8], v[9], v[10], v[11]}; *(f32x4*)(p + 512 + 8 * lane + 4) = (f32x4){v[12], v[13], v[14], v[15]};
}
__device__ __forceinline__ void load16bf(const bf16_t* p, int lane, float (&v)[16]) {
    const u32x4 a = *(const u32x4*)(p + 8 * lane), b = *(const u32x4*)(p + 512 + 8 * lane);
#pragma unroll
    for (int j = 0; j < 4; ++j) { v[2 * j] = bflo(a[j]); v[2 * j + 1] = bfhi(a[j]); v[8 + 2 * j] = bflo(b[j]); v[8 + 2 * j + 1] = bfhi(b[j]); }
}
__device__ __forceinline__ void store16bf(bf16_t* p, int lane, const float (&v)[16]) {
    u32x4 a, b;
#pragma unroll
    for (int j = 0; j < 4; ++j) { a[j] = pk2(v[2 * j], v[2 * j + 1]); b[j] = pk2(v[8 + 2 * j], v[8 + 2 * j + 1]); }
    *(u32x4*)(p + 8 * lane) = a; *(u32x4*)(p + 512 + 8 * lane) = b;
}
__device__ __forceinline__ float sumsq16(const float (&v)[16]) { float s = 0.f;
#pragma unroll
    for (int j = 0; j < 16; ++j) s = fmaf(v[j], v[j], s);
    return s; }

constexpr int HB_LD = 2 * DM;
template <int MODE, bool FIRST>
__device__ __forceinline__ void row_pass(const Frame& F, const float* x_ctx, const float* x_lat, bf16_t* hb, float* outf, const bf16_t* Y, bf16_t* XN,
                                         const float* gpost, const float* gate_mod, const float* gpre, const float* shift_mod, const float* scale_mod) {
    const int gw = F.vcu * 8 + F.wave, lane = F.lane;
    constexpr int RPW = 12;
    float pg[16], gt[16], ng[16], sc[16], sh[16];
    if (MODE != 0) load16(gpost, lane, pg);
    if (MODE != 2) load16(gpre, lane, ng);
    int curb = -1;
    for (int ch = gw; ch < T_ALL / RPW; ch += F.G * 8)
    for (int r = ch * RPW; r < ch * RPW + RPW; ++r) {
        const int b = (r < T_CTX) ? 8 : (r - T_CTX) / SEQ_L;
        if (b != curb) { curb = b;
            if (MODE != 0) load16(gate_mod + (size_t)b * NMOD, lane, gt);
            if (MODE != 2) { load16(scale_mod + (size_t)b * NMOD, lane, sc); load16(shift_mod + (size_t)b * NMOD, lane, sh);
#pragma unroll
                for (int j = 0; j < 16; ++j) sc[j] = (1.0f + sc[j]) * ng[j]; } }
        float h[16];
        if (MODE == 0 || FIRST) { const float* hp = (r < T_CTX) ? x_ctx + (size_t)r * DM : x_lat + (size_t)(r - T_CTX) * DM; load16(hp, lane, h); }
        else load16bf(hb + (size_t)r * HB_LD, lane, h);
        if (MODE != 0) {
            float y[16]; load16bf(Y + (size_t)r * DM, lane, y);
            const float rs = __builtin_amdgcn_rsqf(wave_sum(sumsq16(y)) * (1.0f / DM) + EPS);
#pragma unroll
            for (int j = 0; j < 16; ++j) h[j] = fmaf(gt[j], y[j] * rs * pg[j], h[j]);
            if (MODE == 1) store16bf(hb + (size_t)r * HB_LD, lane, h); else store16f(outf + (size_t)r * DM, lane, h);
        }
        if (MODE != 2) {
            const float rs = __builtin_amdgcn_rsqf(wave_sum(sumsq16(h)) * (1.0f / DM) + EPS);
            float x[16];
#pragma unroll
            for (int j = 0; j < 16; ++j) x[j] = fmaf(h[j] * rs, sc[j], sh[j]);
            store16bf(XN + (size_t)r * DM, lane, x);
        }
    }
}

__device__ __forceinline__ void sincos_d(double x, double& s, double& c) {
    const double k = __builtin_rint(x * 0.63661977236758134308);
    const double r = fma(-k, 6.123233995736766036e-17, fma(-k, 1.57079632679489655800, x));
    const double r2 = r * r;
    double sp = -7.647163731819816476e-13; sp = fma(sp, r2, 1.605904383682161460e-10); sp = fma(sp, r2, -2.505210838544171878e-08); sp = fma(sp, r2, 2.755731922398589065e-06);
    sp = fma(sp, r2, -1.984126984126984127e-04); sp = fma(sp, r2, 8.333333333333333333e-03); sp = fma(sp, r2, -1.666666666666666667e-01); sp = fma(sp * r2, r, r);
    double cp = 4.779477332387385297e-14; cp = fma(cp, r2, -1.147074559772972471e-11); cp = fma(cp, r2, 2.087675698786809898e-09); cp = fma(cp, r2, -2.755731922398589065e-07);
    cp = fma(cp, r2, 2.480158730158730159e-05); cp = fma(cp, r2, -1.388888888888888889e-03); cp = fma(cp, r2, 4.166666666666666667e-02); cp = fma(cp, r2, -0.5); cp = fma(cp, r2, 1.0);
    const int q = ((int)k) & 3;
    s = (q == 0) ? sp : (q == 1) ? cp : (q == 2) ? -sp : -cp;
    c = (q == 0) ? cp : (q == 1) ? -sp : (q == 2) ? -cp : sp;
}

constexpr int N_PHASES = 19;
__device__ __forceinline__ const float* kin_ptr(int i) {
    typedef __attribute__((address_space(4))) const char* kptr_t;
    kptr_t kp = (kptr_t)__builtin_amdgcn_kernarg_segment_ptr();
    asm volatile("" : "+s"(kp));
    typedef const float* fptr_t; typedef __attribute__((address_space(4))) const fptr_t* kfp_t;
    return *(kfp_t)(kp + 8 * i);
}

__global__ void __launch_bounds__(512, 2) mega_fwd(Args args) {
    extern __shared__ __attribute__((aligned(16))) unsigned char lds_raw[];
    Frame F;
    F.lds = (LAS unsigned char*)lds_raw; F.ws = args.ws;
    F.tid = threadIdx.x; F.lane = F.tid & 63; F.wave = __builtin_amdgcn_readfirstlane(F.tid >> 6);
    F.G = gridDim.x; { const int bx = blockIdx.x; F.vcu = (F.G % 8 == 0) ? (bx % 8) * (F.G / 8) + bx / 8 : bx; }
    unsigned char* ws = args.ws;
    unsigned* ctl = (unsigned*)(ws + WS_CTL);
    volatile LAS unsigned* MISC = (volatile LAS unsigned*)(F.lds + MISC_OFF);
    for (int u = F.tid; u < (LDS_BYTES - LDSCTL_OFF) / 4; u += 512) ((LAS unsigned*)(F.lds + LDSCTL_OFF))[u] = 0u;
    __syncthreads();
    XcdBarrier bar; bar.bar = ctl + CW_BAR; bar.x = 0; bar.st = nullptr;
#if MK_N_LAUNCHES == 1
    constexpr int lo = 0, hi = N_PHASES;
#else
    const int lo = args.ph_lo, hi = args.ph_hi;
#endif
    if (hi - lo > 1) bar = xcd_barrier_post(ctl + CW_BAR, MISC + 8);
#ifndef PH_MASK
#define PH_MASK 0x7ffff
#endif
#define IN(k) (((PH_MASK >> (k)) & 1) && lo <= (k) && (k) < hi)
#if PROBE_MASK
    unsigned long long pr_t0 = __builtin_amdgcn_s_memrealtime();
#define PROBE_END(k) do { if ((PROBE_MASK >> (k)) & 1) { const unsigned long long _t1 = __builtin_amdgcn_s_memrealtime(); const unsigned long long _d = _t1 - pr_t0; \
        while (__builtin_amdgcn_s_memrealtime() - _t1 < _d) __builtin_amdgcn_s_sleep(8); } } while (0)
#define PROBE_T0() pr_t0 = __builtin_amdgcn_s_memrealtime()
#else
#define PROBE_END(k) do { } while (0)
#define PROBE_T0() do { } while (0)
#endif
#define SEAM(k) do { PROBE_END(k); if (IN(k) && IN((k) + 1)) xcd_barrier(bar); PROBE_T0(); } while (0)

#define KIN(i) kin_ptr(i)
#define PH_BEGIN() do { int _t = threadIdx.x; asm volatile("" : "+v"(_t)); F.tid = _t; F.lane = _t & 63; } while (0)
    float* H = args.out;
    bf16_t* HB = (bf16_t*)args.out;
    float* new_k = args.out + (size_t)T_ALL * DM; float* new_v = new_k + (size_t)T_CTX * KVW;
    float* MOD = (float*)(ws + WS_MOD); float* ROPE = (float*)(ws + WS_ROPE); float* RAWB = (float*)(ws + WS_RAWB);
    bf16_t* Win_t = (bf16_t*)(ws + WS_WIN); bf16_t* Wout_t = (bf16_t*)(ws + WS_WOUT); bf16_t* Wqkv_t = (bf16_t*)(ws + WS_WQKV); bf16_t* Wo_t = (bf16_t*)(ws + WS_WO);
    bf16_t* Wup_t = (bf16_t*)(ws + WS_WUP); bf16_t* Wdn_t = (bf16_t*)(ws + WS_WDN);
    bf16_t* XN = (bf16_t*)(ws + WS_XN);
    unsigned char* big = ws + WS_BIG;
    bf16_t* CV = (bf16_t*)(big + BIG_CV); bf16_t* A2 = (bf16_t*)(big + BIG_A2); bf16_t* QKV = (bf16_t*)(big + BIG_QKV); bf16_t* OB = (bf16_t*)(big + BIG_O);
    bf16_t* QB = (bf16_t*)(big + BIG_Q); bf16_t* KALL = (bf16_t*)(big + BIG_KALL); bf16_t* VALL = (bf16_t*)(big + BIG_VALL); bf16_t* KC = (bf16_t*)(big + BIG_KC); bf16_t* VC = (bf16_t*)(big + BIG_VC);
    LAS unsigned char* ring = F.lds; LAS unsigned char* xbuf = F.lds + XB_OFF;
    const int gw = F.vcu * 8 + F.wave, NGW = F.G * 8;

    if (IN(0)) { PH_BEGIN();
        const float* const cvec = KIN(4); const float* const c_ctx = KIN(5); const float* const mod_w = KIN(6); const float* const mod_b = KIN(7);
#if PROBE_SUB == 1
        unsigned long long ps0 = __builtin_amdgcn_s_memrealtime();
#endif
        {
            LAS float* sl = (LAS float*)ring;
            for (int it = F.vcu; it < 256; it += F.G) {
                const int layer = it >> 7, cchunk = (it >> 4) & 7, kchunk = it & 15, k0 = kchunk * 64;
                __syncthreads();
                for (int e = F.tid; e < 9 * 64; e += 512) { const int r = e >> 6, k = e & 63; const float v = (r < 8) ? cvec[r * DM + k0 + k] : c_ctx[k0 + k]; sl[e] = silu_f(v); }
                __syncthreads();
                const int ln = (F.lane < 48) ? F.lane : F.lane - 48, n = cchunk * 768 + F.wave * 96 + 2 * ln;
                const float* wp = mod_w + ((size_t)layer * DM + k0) * NMOD + n;
                f32x2 a[9];
#pragma unroll
                for (int r = 0; r < 9; ++r) a[r] = (f32x2){0.f, 0.f};
#pragma unroll 4
                for (int k = 0; k < 64; k += 4) {
                    const f32x2 wa = *(const f32x2*)(wp + (size_t)k * NMOD), wb = *(const f32x2*)(wp + (size_t)(k + 1) * NMOD), wc2 = *(const f32x2*)(wp + (size_t)(k + 2) * NMOD), wd = *(const f32x2*)(wp + (size_t)(k + 3) * NMOD);
#pragma unroll
                    for (int r = 0; r < 9; ++r) { const f32x4 s4 = *(const LAS f32x4*)(sl + r * 64 + k); a[r] = a[r] + wa * s4[0] + wb * s4[1] + wc2 * s4[2] + wd * s4[3]; } }
                if (F.lane < 48) {
                    const f32x2 bias = (kchunk == 0) ? *(const f32x2*)(mod_b + layer * NMOD + n) : (f32x2){0.f, 0.f};
#pragma unroll
                    for (int r = 0; r < 9; ++r) { float* d = MOD + ((size_t)layer * 9 + r) * NMOD + n; atomicAdd(d, a[r].x + bias.x); atomicAdd(d + 1, a[r].y + bias.y); }
                }
            }
            __syncthreads();
        }
#if PROBE_SUB == 1
        { const unsigned long long t1 = __builtin_amdgcn_s_memrealtime(), d = t1 - ps0; while (__builtin_amdgcn_s_memrealtime() - t1 < d) __builtin_amdgcn_s_sleep(8); }
#endif
        if (F.vcu == F.G - 1) {
            for (int e = F.tid; e < 64 * 32; e += 512) { const int pos = e >> 5, i = e & 31;
                double inv = 1.0; for (int q = 0; q < i; ++q) inv *= 0.74989420933245582730;
                double s, c; sincos_d((double)pos * inv, s, c);
                ROPE[2 * e] = (float)c; ROPE[2 * e + 1] = (float)s; }
        }
        {
#if PROBE_SUB == 2
        unsigned long long ps0 = __builtin_amdgcn_s_memrealtime();
#endif
            LAS float* scr = (LAS float*)(ring + F.wave * 16384);
            constexpr int I_IN = 16 * (NIN / 32), I_OUT = 16 * (DM / 32), I_QKV = 16 * (NQKV / 32), I_O = 16 * (DM / 32), I_UP = 16 * (NUP / 32), I_DN = (DFF / 64) * (DM / 32);
            constexpr int NITEMS = I_IN + I_OUT + I_QKV + I_O + 2 * I_UP + 2 * I_DN;
            const float* const conv_w_in = KIN(12); const float* const conv_w_out = KIN(14); const float* const attn_w_qkv = KIN(15); const float* const attn_w_o = KIN(18);
            const float* const ffn_w_up = KIN(19); const float* const ffn_w_down = KIN(21);
            auto item_of = [&](int it) -> TrItem {
                int r = it;
                if (r < I_IN) { const int nb = NIN / 32; return TrItem{conv_w_in, Win_t, NIN, DM, (r % nb) * 32, (r / nb) * 64, (r % nb) * 32}; } r -= I_IN;
                if (r < I_OUT) { const int nb = DM / 32; return TrItem{conv_w_out, Wout_t, DM, DM, (r % nb) * 32, (r / nb) * 64, (r % nb) * 32}; } r -= I_OUT;
                if (r < I_QKV) { const int nb = NQKV / 32; return TrItem{attn_w_qkv, Wqkv_t, NQKV, DM, (r % nb) * 32, (r / nb) * 64, (r % nb) * 32}; } r -= I_QKV;
                if (r < I_O) { const int nb = DM / 32; return TrItem{attn_w_o, Wo_t, DM, DM, (r % nb) * 32, (r / nb) * 64, (r % nb) * 32}; } r -= I_O;
                if (r < 2 * I_UP) { const int layer = r / I_UP; r -= layer * I_UP; const int nb = NUP / 32, n0 = (r % nb) * 32, k0 = (r / nb) * 64;
                    const int bj = n0 / DFF, f = n0 % DFF, dest = (f / 128) * 256 + bj * 128 + (f % 128);
                    return TrItem{ffn_w_up + (size_t)layer * DM * NUP, Wup_t + (size_t)layer * NUP * DM, NUP, DM, dest, k0, n0}; } r -= 2 * I_UP;
                { const int layer = r / I_DN; r -= layer * I_DN; const int nb = DM / 32;
                    return TrItem{ffn_w_down + (size_t)layer * DFF * DM, Wdn_t + (size_t)layer * DM * DFF, DM, DFF, (r % nb) * 32, (r / nb) * 64, (r % nb) * 32}; }
            };
            if (gw < NITEMS) {
                f32x4 va[8], vb[8]; TrItem ta = item_of(gw), tb = ta; tr_load(ta, va, F.lane);
                for (int it = gw; it < NITEMS; it += 2 * NGW) {
                    const bool hb = it + NGW < NITEMS; if (hb) { tb = item_of(it + NGW); tr_load(tb, vb, F.lane); }
                    tr_finish(ta, va, scr, F.lane);
                    if (!hb) break;
                    const bool ha = it + 2 * NGW < NITEMS; if (ha) { ta = item_of(it + 2 * NGW); tr_load(ta, va, F.lane); }
                    tr_finish(tb, vb, scr, F.lane);
                    if (!ha) break;
                }
            }
#if PROBE_SUB == 2
        { const unsigned long long t1 = __builtin_amdgcn_s_memrealtime(), d = t1 - ps0; while (__builtin_amdgcn_s_memrealtime() - t1 < d) __builtin_amdgcn_s_sleep(8); }
#endif
        }
    }
    SEAM(0);
    if (IN(1)) { PH_BEGIN(); row_pass<0, true>(F, KIN(0), KIN(1), nullptr, nullptr, nullptr, XN, nullptr, nullptr, KIN(8), MOD + 0 * DM, MOD + 1 * DM); }
    SEAM(1);
    if (IN(2)) { PH_BEGIN(); pg8::Gemm g{XN, Win_t, T_ALL, NIN, DM, DM, DM}; pg8::StaticOrder S; S.init(T_ALL, NIN, F.G, (int)blockIdx.x, true); pg8::EpiBf16 E{CV, NIN};
        pg8::gemm_phase<pg8::EpiBf16>(ring, xbuf, g, S, E, F.tid); }
    SEAM(2);
    if (IN(3)) { PH_BEGIN();
        const float* const conv_k = KIN(13);
        for (int it = gw; it < (T_ALL / 8) * 2; it += NGW) {
            const int half = it & 1, t0 = (it >> 1) * 8, cb = half * 512 + 8 * F.lane;
            const int p0 = (t0 < T_CTX) ? (t0 & (SEQ_C - 1)) : ((t0 - T_CTX) & (SEQ_L - 1)), L = (t0 < T_CTX) ? SEQ_C : SEQ_L;
            float k0[8], k1[8], k2[8];
            { const f32x4 a = *(const f32x4*)(conv_k + cb), b = *(const f32x4*)(conv_k + cb + 4), c = *(const f32x4*)(conv_k + DM + cb), d = *(const f32x4*)(conv_k + DM + cb + 4),
                  e = *(const f32x4*)(conv_k + 2 * DM + cb), f = *(const f32x4*)(conv_k + 2 * DM + cb + 4);
#pragma unroll
              for (int j = 0; j < 4; ++j) { k0[j] = a[j]; k0[4 + j] = b[j]; k1[j] = c[j]; k1[4 + j] = d[j]; k2[j] = e[j]; k2[4 + j] = f[j]; } }
            float prev[8], cur[8], nxt[8];
#define PROD(dst, t) do { const u32x4 _c = *(const u32x4*)(CV + (size_t)(t) * NIN + DM + cb), _x = *(const u32x4*)(CV + (size_t)(t) * NIN + 2 * DM + cb); \
                _Pragma("unroll") for (int j = 0; j < 4; ++j) { dst[2 * j] = bflo(_c[j]) * bflo(_x[j]); dst[2 * j + 1] = bfhi(_c[j]) * bfhi(_x[j]); } } while (0)
#pragma unroll
            for (int j = 0; j < 8; ++j) prev[j] = 0.f;
            if (p0 > 0) PROD(prev, t0 - 1);
            PROD(cur, t0);
#pragma unroll
            for (int r = 0; r < 8; ++r) {
#pragma unroll
                for (int j = 0; j < 8; ++j) nxt[j] = 0.f;
                if (p0 + r + 1 < L) PROD(nxt, t0 + r + 1);
                bf16_t* bp = CV + (size_t)(t0 + r) * NIN + cb;
                const u32x4 bv = *(const u32x4*)bp; u32x4 o;
#pragma unroll
                for (int j = 0; j < 4; ++j) {
                    const float z0 = bflo(bv[j]) * fmaf(k2[2 * j], nxt[2 * j], fmaf(k1[2 * j], cur[2 * j], k0[2 * j] * prev[2 * j]));
                    const float z1 = bfhi(bv[j]) * fmaf(k2[2 * j + 1], nxt[2 * j + 1], fmaf(k1[2 * j + 1], cur[2 * j + 1], k0[2 * j + 1] * prev[2 * j + 1]));
                    o[j] = pk2(z0, z1); }
                *(u32x4*)bp = o;
#pragma unroll
                for (int j = 0; j < 8; ++j) { prev[j] = cur[j]; cur[j] = nxt[j]; }
            }
#undef PROD
        }
    }
    SEAM(3);
    if (IN(4)) { PH_BEGIN(); pg8::Gemm g{CV, Wout_t, T_ALL, DM, DM, NIN, DM}; pg8::StaticOrder S; S.init(T_ALL, DM, F.G, (int)blockIdx.x, true); pg8::EpiBf16 E{XN, DM};
        pg8::gemm_phase<pg8::EpiBf16>(ring, xbuf, g, S, E, F.tid); }
    SEAM(4);
    if (IN(5)) { PH_BEGIN(); row_pass<1, true>(F, KIN(0), KIN(1), HB, nullptr, XN, XN, KIN(9), MOD + 2 * DM, KIN(10), MOD + 3 * DM, MOD + 4 * DM); }
    SEAM(5);
#define FFN_UP(l) do { pg8::Gemm g{XN, Wup_t + (size_t)(l) * NUP * DM, T_ALL, NUP, DM, DM, DM}; pg8::StaticOrder S; S.init(T_ALL, NUP, F.G, (int)blockIdx.x); \
        pg8::EpiFfn E{A2, KIN(20) + (size_t)(l) * 3 * NUP, RAWB}; pg8::gemm_phase<pg8::EpiFfn>(ring, xbuf, g, S, E, F.tid); } while (0)
#define FFN_FIX_ROW(cw, lt, sel) do { \
        const float* rm = RAWB + (size_t)((lt) * 4 + ((sel) ? 3 : 2)) * NUP; const float* rc = RAWB + (size_t)((sel) ? ((lt) + 1) * 4 + 0 : (lt) * 4 + 3) * NUP; const float* rp = RAWB + (size_t)(((lt) + 1) * 4 + ((sel) ? 1 : 0)) * NUP; \
        const int row = T_CTX + 256 * ((lt) + (sel)) + ((sel) ? 0 : 255); \
        for (int f = 4 * F.tid; f < DFF; f += 2048) { float a[4]; \
            const f32x4 g0 = *(const f32x4*)(rm + f), g1 = *(const f32x4*)(rc + f), g2 = *(const f32x4*)(rp + f), u0 = *(const f32x4*)(rm + DFF + f), u1 = *(const f32x4*)(rc + DFF + f), u2 = *(const f32x4*)(rp + DFF + f); \
            const f32x4 wg0 = *(const f32x4*)((cw) + f), wg1 = *(const f32x4*)((cw) + NUP + f), wg2 = *(const f32x4*)((cw) + 2 * NUP + f), wu0 = *(const f32x4*)((cw) + DFF + f), wu1 = *(const f32x4*)((cw) + NUP + DFF + f), wu2 = *(const f32x4*)((cw) + 2 * NUP + DFF + f); \
            _Pragma("unroll") for (int j = 0; j < 4; ++j) { float gc = wg1[j] * g1[j]; gc = fmaf(g0[j], wg0[j], gc); gc = fmaf(g2[j], wg2[j], gc); float uc = wu1[j] * u1[j]; uc = fmaf(u0[j], wu0[j], uc); uc = fmaf(u2[j], wu2[j], uc); a[j] = silu_f(gc) * uc; } \
            u32x2 w; w.x = cvt_pk_bf16(a[0], a[1]); w.y = cvt_pk_bf16(a[2], a[3]); *(u32x2*)(A2 + (size_t)row * DFF + f) = w; } } while (0)
#define FFN_DOWN(l) do { pg8::Gemm g{A2, Wdn_t + (size_t)(l) * DM * DFF, T_ALL, DM, DFF, DFF, DFF}; pg8::StaticOrder S; S.init(T_ALL, DM, F.G, (int)blockIdx.x, true); pg8::EpiBf16 E{XN, DM}; \
        { const float* cw = KIN(20) + (size_t)(l) * 3 * NUP; pg8::Unit uu; \
          for (int i = 0; S.next(i, uu); ++i) if (uu.pm >= 32) { const int lt = uu.pm - 32, ti = lt & 7; \
              if (ti != 0 && uu.half != 1) FFN_FIX_ROW(cw, lt - 1, 1);        \
              if (ti != 7 && uu.half != 0) FFN_FIX_ROW(cw, lt, 0); }           \
          VM_WAIT(); __syncthreads(); } \
        pg8::gemm_phase<pg8::EpiBf16>(ring, xbuf, g, S, E, F.tid); } while (0)
    if (IN(6)) { PH_BEGIN(); FFN_UP(0); }
    SEAM(6);
    if (IN(8)) { PH_BEGIN(); FFN_DOWN(0); }
    SEAM(8);
    if (IN(9)) { PH_BEGIN(); row_pass<1, false>(F, nullptr, nullptr, HB, nullptr, XN, XN, KIN(11), MOD + 5 * DM, KIN(8) + DM, MOD + (size_t)9 * NMOD + 0 * DM, MOD + (size_t)9 * NMOD + 1 * DM); }
    SEAM(9);
    if (IN(10)) { PH_BEGIN(); pg8::Gemm g{XN, Wqkv_t, T_ALL, NQKV, DM, DM, DM}; pg8::StaticOrder S; S.init(T_ALL, NQKV, F.G, (int)blockIdx.x, true); pg8::EpiBf16 E{QKV, NQKV};
        pg8::gemm_phase<pg8::EpiBf16>(ring, xbuf, g, S, E, F.tid); }
    SEAM(10);
    if (IN(11)) { PH_BEGIN();
        const float* const cache_k = KIN(2); const float* const cache_v = KIN(3); const float* const q_gain = KIN(16); const float* const k_gain = KIN(17);
        for (size_t i = (size_t)gw * 64 + F.lane; i < (size_t)8 * PAST * KVW / 8; i += (size_t)NGW * 64) {
            const size_t e = i * 8; const int b = (int)(e / ((size_t)PAST * KVW)); const size_t w = e % ((size_t)PAST * KVW);
            const f32x4 k0 = *(const f32x4*)(cache_k + e), k1 = *(const f32x4*)(cache_k + e + 4), v0 = *(const f32x4*)(cache_v + e), v1 = *(const f32x4*)(cache_v + e + 4);
            u32x4 ko, vo; ko.x = pk2(k0[0], k0[1]); ko.y = pk2(k0[2], k0[3]); ko.z = pk2(k1[0], k1[1]); ko.w = pk2(k1[2], k1[3]);
            vo.x = pk2(v0[0], v0[1]); vo.y = pk2(v0[2], v0[3]); vo.z = pk2(v1[0], v1[1]); vo.w = pk2(v1[2], v1[3]);
            *(u32x4*)(KALL + (size_t)b * KV_LAT * KVW + w) = ko; *(u32x4*)(VALL + (size_t)b * KV_LAT * KVW + w) = vo;
        }
        const int cc = F.lane & 15;
        float qg[8], kg[8];
        { const f32x4 a = *(const f32x4*)(q_gain + 8 * cc), b = *(const f32x4*)(q_gain + 8 * cc + 4), c = *(const f32x4*)(k_gain + 8 * cc), d = *(const f32x4*)(k_gain + 8 * cc + 4);
#pragma unroll
          for (int j = 0; j < 4; ++j) { qg[j] = a[j]; qg[4 + j] = b[j]; kg[j] = c[j]; kg[4 + j] = d[j]; } }
        for (int t = gw; t < T_ALL; t += NGW) {
            const bool lat = t >= T_CTX; const int tl = t - T_CTX, bl = tl / SEQ_L, tt = tl % SEQ_L;
            float cs[8], sn[8];
            if (lat) { const int pos = (cc < 8) ? (tt >> 6) : (tt & 63); const float* rp = ROPE + ((size_t)pos * 32 + 8 * (cc & 3)) * 2;
                const f32x4 r0 = *(const f32x4*)rp, r1 = *(const f32x4*)(rp + 4), r2 = *(const f32x4*)(rp + 8), r3 = *(const f32x4*)(rp + 12);
                cs[0] = r0[0]; sn[0] = r0[1]; cs[1] = r0[2]; sn[1] = r0[3]; cs[2] = r1[0]; sn[2] = r1[1]; cs[3] = r1[2]; sn[3] = r1[3];
                cs[4] = r2[0]; sn[4] = r2[1]; cs[5] = r2[2]; sn[5] = r2[3]; cs[6] = r3[0]; sn[6] = r3[1]; cs[7] = r3[2]; sn[7] = r3[3]; }
            const float sgn = ((cc & 7) < 4) ? -1.f : 1.f;
#pragma unroll
            for (int k = 0; k < 3; ++k) {
                const int c = F.lane + 64 * k, head = c >> 4;
                const u32x4 raw = *(const u32x4*)(QKV + (size_t)t * NQKV + 8 * c);
                float x[8];
#pragma unroll
                for (int j = 0; j < 4; ++j) { x[2 * j] = bflo(raw[j]); x[2 * j + 1] = bfhi(raw[j]); }
                const bool isv = (k == 2) && (F.lane >= 32), isq = (k < 2);
                {
                    float s = 0.f;
#pragma unroll
                    for (int j = 0; j < 8; ++j) s = fmaf(x[j], x[j], s);
                    s += __shfl_xor(s, 1); s += __shfl_xor(s, 2); s += __shfl_xor(s, 4); s += __shfl_xor(s, 8);
                    const float rs = __builtin_amdgcn_rsqf(s * (1.0f / HD) + EPS);
#pragma unroll
                    for (int j = 0; j < 8; ++j) x[j] = isv ? x[j] : x[j] * rs * (isq ? qg[j] : kg[j]);
                }
                float y[8];
#pragma unroll
                for (int j = 0; j < 8; ++j) { const float p = __shfl_xor(x[j], 4); y[j] = (lat && !isv) ? fmaf(x[j], cs[j], sgn * p * sn[j]) : x[j]; }
                u32x4 o; o.x = pk2(y[0], y[1]); o.y = pk2(y[2], y[3]); o.z = pk2(y[4], y[5]); o.w = pk2(y[6], y[7]);
                if (isq) { *(u32x4*)(QB + (size_t)t * DM + 8 * c) = o; }
                else {
                    const int kvc = 8 * (c - 128 - (isv ? 32 : 0));
                    if (lat) { bf16_t* dst = (isv ? VALL : KALL) + ((size_t)bl * KV_LAT + PAST + tt) * KVW + kvc; *(u32x4*)dst = o; }
                    else { bf16_t* dst = (isv ? VC : KC) + (size_t)t * KVW + kvc; *(u32x4*)dst = o;
                        float* nd = (isv ? new_v : new_k) + (size_t)t * KVW + kvc;
                        *(f32x4*)nd = (f32x4){y[0], y[1], y[2], y[3]}; *(f32x4*)(nd + 4) = (f32x4){y[4], y[5], y[6], y[7]}; }
                }
            }
        }
    }
    SEAM(11);
    if (IN(12)) { PH_BEGIN();
        char* albs = (char*)lds_raw;
        const int xg = (int)blockIdx.x & 7, j = (int)blockIdx.x >> 3;
        const int n_lat = 512, n_all = 512 + 256;
        for (int it0 = 0; ; ++it0) {
            int it;
            if (F.G == 256) { if (it0 >= 3) break; it = (it0 < 2) ? ((2 * xg + it0) * 32 + j) : (512 + F.vcu); }
            else { it = (int)blockIdx.x + it0 * F.G; if (it >= n_all) break; }
            const bf16_t *qp, *kp, *vp; bf16_t* op; int seq;
            if (it < n_lat) { const int grp = it >> 5, jj = it & 31, b = grp >> 1, kvh = grp & 1, h = kvh * 4 + (jj >> 3), qb = jj & 7;
                const size_t qo = ((size_t)(T_CTX + b * SEQ_L + qb * 256)) * DM + h * HD, ko = (size_t)b * KV_LAT * KVW + kvh * HD;
                qp = QB + qo; op = OB + qo; kp = KALL + ko; vp = VALL + ko; seq = KV_LAT; }
            else { const int ic = it - n_lat, b = ic >> 3, h = ic & 7, kvh = h >> 2;
                const size_t qo = (size_t)(b * SEQ_C) * DM + h * HD, ko = (size_t)(b * SEQ_C) * KVW + kvh * HD;
                qp = QB + qo; op = OB + qo; kp = KC + ko; vp = VC + ko; seq = SEQ_C; }
            __syncthreads();
            att::attn_dense_body(qp, kp, vp, op, seq, albs, F.tid);
        }
        __syncthreads();
    }
    SEAM(12);
    if (IN(13)) { PH_BEGIN(); pg8::Gemm g{OB, Wo_t, T_ALL, DM, DM, DM, DM}; pg8::StaticOrder S; S.init(T_ALL, DM, F.G, (int)blockIdx.x, true); pg8::EpiBf16 E{XN, DM};
        pg8::gemm_phase<pg8::EpiBf16>(ring, xbuf, g, S, E, F.tid); }
    SEAM(13);
    if (IN(14)) { PH_BEGIN(); row_pass<1, false>(F, nullptr, nullptr, HB, nullptr, XN, XN, KIN(9) + DM, MOD + (size_t)9 * NMOD + 2 * DM, KIN(10) + DM, MOD + (size_t)9 * NMOD + 3 * DM, MOD + (size_t)9 * NMOD + 4 * DM); }
    SEAM(14);
    if (IN(15)) { PH_BEGIN(); FFN_UP(1); }
    SEAM(15);
    if (IN(17)) { PH_BEGIN(); FFN_DOWN(1); }
    SEAM(17);
    if (IN(18)) { PH_BEGIN(); row_pass<2, false>(F, nullptr, nullptr, HB, H, XN, nullptr, KIN(11) + DM, MOD + (size_t)9 * NMOD + 5 * DM, nullptr, nullptr, nullptr); }
    PROBE_END(18);
#undef IN
#undef SEAM
}

extern "C" void kernel_launch(void* const* d_in, const int* in_sizes, int n_in, void* d_out, int out_size, void* d_ws, size_t ws_size, hipStream_t stream) {
    static int grid = 0;
    if (grid == 0) {
        const long want_out = (long)T_ALL * DM + 2L * T_CTX * KVW;
        if (n_in != 22 || in_sizes[0] != T_CTX * DM || in_sizes[1] != T_LAT * DM || (long)out_size != want_out || ws_size < WS_END) {
            fprintf(stderr, "kernel_launch: shape mismatch (n_in %d out %d ws %zu)\n", n_in, out_size, ws_size); grid = -1; return; }
        int dev = 0, cus = 0;
        if (hipGetDevice(&dev) != hipSuccess || hipDeviceGetAttribute(&cus, hipDeviceAttributeMultiprocessorCount, dev) != hipSuccess) { grid = -1; return; }
        if (hipFuncSetAttribute((const void*)mega_fwd, hipFuncAttributeMaxDynamicSharedMemorySize, LDS_BYTES) != hipSuccess) { fprintf(stderr, "kernel_launch: hipFuncSetAttribute failed\n"); grid = -1; return; }
        int per_cu = 0;
        if (hipOccupancyMaxActiveBlocksPerMultiprocessor(&per_cu, (const void*)mega_fwd, 512, LDS_BYTES) != hipSuccess || per_cu < 1) fprintf(stderr, "kernel_launch: occupancy query says %d\n", per_cu);
        (void)hipGetLastError();
        grid = cus;
    }
    if (grid < 0) return;
    (void)hipMemsetAsync((char*)d_ws + WS_CTL, 0, CTL_ZERO_BYTES, stream);
    (void)hipMemsetAsync((char*)d_ws + WS_MOD, 0, (size_t)2 * 9 * NMOD * 4, stream);
    Args a{};
    for (int i = 0; i < 22; ++i) a.in[i] = (const float*)d_in[i];
    a.out = (float*)d_out; a.ws = (unsigned char*)d_ws;
#if MK_N_LAUNCHES == 1
    a.ph_lo = 0; a.ph_hi = N_PHASES;
    hipLaunchKernelGGL(mega_fwd, dim3(grid), dim3(512), LDS_BYTES, stream, a);
#else
    for (int p = 0; p < N_PHASES; ++p) { a.ph_lo = p; a.ph_hi = p + 1; hipLaunchKernelGGL(mega_fwd, dim3(grid), dim3(512), LDS_BYTES, stream, a); }
#endif
    const hipError_t le = hipPeekAtLastError();
    if (le != hipSuccess) fprintf(stderr, "kernel_launch: launch failed: %s\n", hipGetErrorName(le));
}
```

```cpp
#include <hip/hip_runtime.h>
#include <cstdio>
#include <cstdint>

#ifndef MK_N_LAUNCHES
#define MK_N_LAUNCHES 1
#endif
#define EPI_TWICE 0
#define PROBE_SUB 0
#define PROBE_MASK 0x0

#define GAS __attribute__((address_space(1)))
#define LAS __attribute__((address_space(3)))
typedef unsigned short bf16_t;
typedef short bf16x8 __attribute__((ext_vector_type(8)));
typedef short s16x4 __attribute__((ext_vector_type(4)));
typedef float f32x4 __attribute__((ext_vector_type(4)));
typedef float f32x2 __attribute__((ext_vector_type(2)));
typedef float f32x16 __attribute__((ext_vector_type(16)));
typedef unsigned u32x4 __attribute__((ext_vector_type(4)));
typedef unsigned u32x2 __attribute__((ext_vector_type(2)));

constexpr int DM = 1024, T_CTX = 8192, T_LAT = 16384, T_ALL = T_CTX + T_LAT, SEQ_C = 256, SEQ_L = 2048, PAST = 512, KV_LAT = PAST + SEQ_L;
constexpr int DFF = 2816, NUP = 2 * DFF, NQKV = 1536, NIN = 3072, NMOD = 6 * DM, HD = 128, NKVH = 2, NQH = 8, KVW = NKVH * HD;
constexpr float EPS = 1e-6f;

constexpr size_t MiB = 1u << 20;
constexpr size_t WS_CTL = 0, CTL_ZERO_BYTES = 64 * 1024;
constexpr size_t WS_MOD = 1 * MiB;
constexpr size_t WS_ROPE = 1 * MiB + 512 * 1024;
constexpr size_t WS_RAWB = 2 * MiB;
constexpr size_t WS_WIN = 8 * MiB, WS_WOUT = 14 * MiB, WS_WQKV = 16 * MiB, WS_WO = 19 * MiB, WS_WUP = 21 * MiB, WS_WDN = 43 * MiB;
constexpr size_t WS_XN = 54 * MiB;
constexpr size_t WS_BIG = 102 * MiB;
constexpr size_t WS_END = 250 * MiB;
constexpr size_t BIG_CV = 0;
constexpr size_t BIG_A2 = 0;
constexpr size_t BIG_QKV = 0, BIG_O = 0;
constexpr size_t BIG_Q = 72 * MiB, BIG_KALL = 120 * MiB, BIG_VALL = 130 * MiB, BIG_KC = 140 * MiB, BIG_VC = 144 * MiB;
constexpr int CW_BAR = 1024;

constexpr int RING_BYTES = 131072, XB_OFF = RING_BYTES, XB_BYTES = 8192, LDSCTL_OFF = XB_OFF + XB_BYTES, MISC_OFF = LDSCTL_OFF + 64, LDS_BYTES = 147456;

__device__ __forceinline__ unsigned f2bf(float f) { unsigned u = __builtin_bit_cast(unsigned, f); return (u + 0x7fffu + ((u >> 16) & 1u)) >> 16; }
__device__ __forceinline__ unsigned pk2(float lo, float hi) { return f2bf(lo) | (f2bf(hi) << 16); }
__device__ __forceinline__ float bflo(unsigned w) { return __builtin_bit_cast(float, w << 16); }
__device__ __forceinline__ float bfhi(unsigned w) { return __builtin_bit_cast(float, w & 0xffff0000u); }
__device__ __forceinline__ unsigned cvt_pk_bf16(float lo, float hi) { unsigned r; asm volatile("v_cvt_pk_bf16_f32 %0, %1, %2" : "=v"(r) : "v"(lo), "v"(hi)); return r; }
__device__ __forceinline__ float wave_sum(float v) {
#pragma unroll
    for (int o = 1; o < 64; o <<= 1) v += __shfl_xor(v, o);
    return v;
}
__device__ __forceinline__ float silu_f(float x) { const float e = __builtin_amdgcn_exp2f(-x * 1.4426950408889634f); return x * __builtin_amdgcn_rcpf(1.0f + e); }
#define LDS_WAIT() asm volatile("s_waitcnt lgkmcnt(0)" ::: "memory")
#define VM_WAIT() asm volatile("s_waitcnt vmcnt(0)" ::: "memory")

namespace pg8 {
constexpr int BM = 256, BK = 64, HALF = 128, HTB = HALF * BK * 2, STAGE_BYTES = 8 * HTB, NXCD = 8, WGM = 8;
__device__ __forceinline__ int lds_byte(int r, int c) { const int st = (r >> 4) * 2 + (c >> 5), rr = r & 15, cc = c & 31, ob = rr * 64 + cc * 2; return st * 1024 + (ob ^ (((ob >> 9) & 1) << 5)); }
__device__ __forceinline__ void stage_rc(int b, int& R, int& C) { const int st = b / 1024, sb = b % 1024, swz = sb ^ (((sb >> 9) & 1) << 5); R = (st >> 1) * 16 + swz / 64; C = (st & 1) * 32 + (swz % 64) / 2; }
__device__ __forceinline__ int perm32(int rho) { const int n = rho >> 4, i = rho & 15; return 8 * (i >> 2) + 4 * n + (i & 3); }

struct Unit { int pm, pn, half; };
struct Gemm { const bf16_t* A; const bf16_t* Bt; int M, N, K, lda, ldb; };

struct StaticOrder {
    int nM, nN, nwg, G, c, F, R; bool split;
    __device__ __forceinline__ void init(int M, int N, int G_, int c_, bool split_last = false) { nM = M / BM; nN = N / BM; nwg = nM * nN; G = G_; c = c_; F = nwg / G; R = nwg % G; split = split_last && R > 0 && 2 * R <= G; }
    __device__ __forceinline__ bool next(int i, Unit& u) const {
        long L;
        if (split && i >= F) { if (i > F || c >= 2 * R) return false; L = (long)F * G + (c >> 1); u.half = c & 1; }
        else { L = (long)i * G + c; if (L >= nwg) return false; u.half = -1; }
        int wgid = (int)L; { const int q = nwg / NXCD, r = nwg % NXCD, xcd = wgid % NXCD, off = wgid / NXCD; wgid = (xcd < r ? xcd * (q + 1) : r * (q + 1) + (xcd - r) * q) + off; }
        const int nig = WGM * nN, gid = wgid / nig, fm = gid * WGM, gsz = (nM - fm) < WGM ? (nM - fm) : WGM;
        u.pm = fm + ((wgid % nig) % gsz); u.pn = (wgid % nig) / gsz; return true;
    }
};

struct EpiBf16 {
    static constexpr bool PERM = true, ROWPERM = false;
    __device__ __forceinline__ static int nstores(const Unit& u) { return u.half < 0 ? 16 : 8; }
    bf16_t* O; int ldc;
    __device__ __forceinline__ void operator()(const f32x4 (&acc)[2][2][4][2], const Unit& u, int wr, int wc, int fr, int fq, LAS unsigned char*, int) const {
        const int row0 = u.pm * BM + (u.half > 0 ? HALF : 0) + wr * 64 + fr; const int col0 = u.pn * BM + wc * 32 + 8 * fq;
#pragma unroll
        for (int ai = 0; ai < 2; ++ai) if (ai == 0 || u.half < 0)
#pragma unroll
            for (int m = 0; m < 4; ++m) { bf16_t* rowp = O + (size_t)(row0 + ai * HALF + m * 16) * ldc + col0;
#pragma unroll
                for (int bj = 0; bj < 2; ++bj) { const f32x4 v0 = acc[ai][bj][m][0], v1 = acc[ai][bj][m][1];
                    u32x4 w; w.x = cvt_pk_bf16(v0[0], v0[1]); w.y = cvt_pk_bf16(v0[2], v0[3]); w.z = cvt_pk_bf16(v1[0], v1[1]); w.w = cvt_pk_bf16(v1[2], v1[3]);
                    *(u32x4*)(rowp + bj * HALF) = w; } }
    }
};

__device__ __forceinline__ float dpp_shr1(float x) { return __builtin_bit_cast(float, __builtin_amdgcn_update_dpp(0, __builtin_bit_cast(int, x), 0x111, 0xf, 0xf, true)); }
__device__ __forceinline__ float dpp_shl1(float x) { return __builtin_bit_cast(float, __builtin_amdgcn_update_dpp(0, __builtin_bit_cast(int, x), 0x101, 0xf, 0xf, true)); }
__device__ __forceinline__ float dpp_ror1(float x) { return __builtin_bit_cast(float, __builtin_amdgcn_update_dpp(0, __builtin_bit_cast(int, x), 0x121, 0xf, 0xf, true)); }
__device__ __forceinline__ float dpp_ror15(float x) { return __builtin_bit_cast(float, __builtin_amdgcn_update_dpp(0, __builtin_bit_cast(int, x), 0x12F, 0xf, 0xf, true)); }

struct EpiFfn {
    static constexpr bool PERM = true, ROWPERM = true;
    __device__ __forceinline__ static int nstores(const Unit&) { return 32; }
    bf16_t* A2; const float* cw; float* rawb;
    __device__ __forceinline__ void operator()(const f32x4 (&acc)[2][2][4][2], const Unit& u, int wr, int wc, int fr, int fq, LAS unsigned char* xb, int lane) const {
        (void)lane;
        const int ccol = wc * 32 + 8 * fq;
        const int f0 = u.pn * HALF + ccol;
        LAS float* XB = (LAS float*)xb;
        if (fr == 0) {
#pragma unroll
            for (int ai = 0; ai < 2; ++ai)
#pragma unroll
                for (int bj = 0; bj < 2; ++bj)
#pragma unroll
                    for (int n = 0; n < 2; ++n) *(LAS f32x4*)(XB + (ai * 4 + wr * 2 + 0) * 256 + bj * HALF + ccol + 4 * n) = acc[ai][bj][0][n];
        }
        if (fr == 15) {
#pragma unroll
            for (int ai = 0; ai < 2; ++ai)
#pragma unroll
                for (int bj = 0; bj < 2; ++bj)
#pragma unroll
                    for (int n = 0; n < 2; ++n) *(LAS f32x4*)(XB + (ai * 4 + wr * 2 + 1) * 256 + bj * HALF + ccol + 4 * n) = acc[ai][bj][3][n];
        }
        if (u.pm >= 32) {
            const int lt = u.pm - 32;
            if (wr == 0 && fr == 0) {
#pragma unroll
                for (int q = 0; q < 2; ++q)
#pragma unroll
                    for (int bj = 0; bj < 2; ++bj)
#pragma unroll
                        for (int n = 0; n < 2; ++n) *(f32x4*)(rawb + (size_t)(lt * 4 + q) * NUP + bj * DFF + f0 + 4 * n) = acc[0][bj][q][n];
            }
            if (wr == 1 && fr == 15) {
#pragma unroll
                for (int q = 2; q < 4; ++q)
#pragma unroll
                    for (int bj = 0; bj < 2; ++bj)
#pragma unroll
                        for (int n = 0; n < 2; ++n) *(f32x4*)(rawb + (size_t)(lt * 4 + q) * NUP + bj * DFF + f0 + 4 * n) = acc[1][bj][q][n];
            }
        }
        f32x4 w0[2][2], w1[2][2], w2[2][2];
#pragma unroll
        for (int n = 0; n < 2; ++n)
#pragma unroll
            for (int bj = 0; bj < 2; ++bj) { const float* p = cw + bj * DFF + f0 + 4 * n; w0[bj][n] = *(const f32x4*)p; w1[bj][n] = *(const f32x4*)(p + NUP); w2[bj][n] = *(const f32x4*)(p + 2 * NUP); }
        asm volatile("s_waitcnt lgkmcnt(0)" ::: "memory"); __builtin_amdgcn_s_barrier(); asm volatile("" ::: "memory");
        const float e0 = (fr == 0) ? 1.f : 0.f, e15 = (fr == 15) ? 1.f : 0.f;
#pragma unroll
        for (int n = 0; n < 2; ++n) {
#pragma unroll
            for (int ai = 0; ai < 2; ++ai) {
                const bool hasp = !(ai == 0 && wr == 0), hasn = !(ai == 1 && wr == 1);
                const int pslot = (wr == 1) ? (ai * 4 + 0 * 2 + 1) : (0 * 4 + 1 * 2 + 1);
                const int nslot = (wr == 0) ? (ai * 4 + 1 * 2 + 0) : (1 * 4 + 0 * 2 + 0);
                f32x4 cv[2][4];
#pragma unroll
                for (int bj = 0; bj < 2; ++bj) {
                    const f32x4 pe = hasp ? *(LAS f32x4*)(XB + pslot * 256 + bj * HALF + ccol + 4 * n) : (f32x4){0.f, 0.f, 0.f, 0.f};
                    const f32x4 ne = hasn ? *(LAS f32x4*)(XB + nslot * 256 + bj * HALF + ccol + 4 * n) : (f32x4){0.f, 0.f, 0.f, 0.f};
                    const f32x4 a0 = w0[bj][n], a1 = w1[bj][n], a2 = w2[bj][n];
                    const f32x4 x0 = acc[ai][bj][0][n], x1 = acc[ai][bj][1][n], x2 = acc[ai][bj][2][n], x3 = acc[ai][bj][3][n];
                    f32x4 c0 = a1 * x0 + a2 * x1 + (a0 * e0) * pe;
                    const f32x4 c1 = a0 * x0 + a1 * x1 + a2 * x2;
                    const f32x4 c2 = a0 * x1 + a1 * x2 + a2 * x3;
                    f32x4 c3 = a0 * x2 + a1 * x3 + (a2 * e15) * ne;
                    float c00 = c0[0], c01 = c0[1], c02 = c0[2], c03 = c0[3], c30 = c3[0], c31 = c3[1], c32 = c3[2], c33 = c3[3];
                    asm volatile(
                        "s_nop 1\n\t"
                        "v_fmac_f32_dpp %0, %8, %16 row_shr:1 row_mask:0xf bank_mask:0xf bound_ctrl:1\n\t"
                        "v_fmac_f32_dpp %1, %9, %17 row_shr:1 row_mask:0xf bank_mask:0xf bound_ctrl:1\n\t"
                        "v_fmac_f32_dpp %2, %10, %18 row_shr:1 row_mask:0xf bank_mask:0xf bound_ctrl:1\n\t"
                        "v_fmac_f32_dpp %3, %11, %19 row_shr:1 row_mask:0xf bank_mask:0xf bound_ctrl:1\n\t"
                        "v_fmac_f32_dpp %4, %12, %20 row_shl:1 row_mask:0xf bank_mask:0xf bound_ctrl:1\n\t"
                        "v_fmac_f32_dpp %5, %13, %21 row_shl:1 row_mask:0xf bank_mask:0xf bound_ctrl:1\n\t"
                        "v_fmac_f32_dpp %6, %14, %22 row_shl:1 row_mask:0xf bank_mask:0xf bound_ctrl:1\n\t"
                        "v_fmac_f32_dpp %7, %15, %23 row_shl:1 row_mask:0xf bank_mask:0xf bound_ctrl:1"
                        : "+v"(c00), "+v"(c01), "+v"(c02), "+v"(c03), "+v"(c30), "+v"(c31), "+v"(c32), "+v"(c33)
                        : "v"(x3[0]), "v"(x3[1]), "v"(x3[2]), "v"(x3[3]), "v"(x0[0]), "v"(x0[1]), "v"(x0[2]), "v"(x0[3]),
                          "v"(a0[0]), "v"(a0[1]), "v"(a0[2]), "v"(a0[3]), "v"(a2[0]), "v"(a2[1]), "v"(a2[2]), "v"(a2[3]));
                    cv[bj][0] = (f32x4){c00, c01, c02, c03}; cv[bj][1] = c1; cv[bj][2] = c2; cv[bj][3] = (f32x4){c30, c31, c32, c33};
                }
#pragma unroll
                for (int m = 0; m < 4; ++m) {
                    const f32x4 g = cv[0][m], t = g * (-1.4426950408889634f);
                    f32x4 d; d[0] = __builtin_amdgcn_exp2f(t[0]); d[1] = __builtin_amdgcn_exp2f(t[1]); d[2] = __builtin_amdgcn_exp2f(t[2]); d[3] = __builtin_amdgcn_exp2f(t[3]);
                    d = d + 1.0f;
                    f32x4 r; r[0] = __builtin_amdgcn_rcpf(d[0]); r[1] = __builtin_amdgcn_rcpf(d[1]); r[2] = __builtin_amdgcn_rcpf(d[2]); r[3] = __builtin_amdgcn_rcpf(d[3]);
                    const f32x4 a = (g * r) * cv[1][m];
                    u32x2 w; w.x = cvt_pk_bf16(a[0], a[1]); w.y = cvt_pk_bf16(a[2], a[3]);
                    const int row = u.pm * BM + ai * HALF + wr * 64 + 4 * fr + m;
                    *(u32x2*)(A2 + (size_t)row * DFF + f0 + 4 * n) = w;
                }
            }
        }
    }
};

template <class Epi, bool ALIGN_EPI = true, bool SP2 = true>
__device__ __forceinline__ void gemm_phase(LAS unsigned char* lds, LAS unsigned char* xb, const Gemm g, const StaticOrder& S, const Epi& E, const int tid) {
    const int wid = __builtin_amdgcn_readfirstlane(tid >> 6), lane = tid & 63, wr = wid >> 2, wc = wid & 3, fr = lane & 15, fq = lane >> 4;
    const int K = g.K, nt = K / BK;
    unsigned voffA[2], voffB[2];
#pragma unroll
    for (int i = 0; i < 2; ++i) { int R, C; stage_rc(tid * 16 + i * 8192, R, C); const int Rb = Epi::PERM ? ((R & ~31) + perm32(R & 31)) : R;
        const int Ra = Epi::ROWPERM ? ((R & ~63) + 4 * (R & 15) + ((R >> 4) & 3)) : R;
        voffA[i] = (unsigned)(Ra * g.lda + C) * 2u; voffB[i] = (unsigned)(Rb * g.ldb + C) * 2u; }
    const size_t kstep = (size_t)(BK * 2);
    const size_t hstepA = (size_t)HALF * g.lda * 2, hstepB = (size_t)HALF * g.ldb * 2;
    const size_t tstepA = 2 * hstepA, tstepB = 2 * hstepB;
    const unsigned ldsw = (unsigned)wid * 1024u;
    const int aoff = lds_byte(wr * 64 + fr, fq * 8), boff = lds_byte(wc * 32 + fr, fq * 8);
#define PG8_SA(b, h) (((b) * 2 + (h)) * HTB)
#define PG8_SB(b, h) ((4 + (b) * 2 + (h)) * HTB)
#define PG8_STAGE(bufoff, gbase, voff) do { _Pragma("unroll") for (int _i = 0; _i < 2; ++_i) \
        __builtin_amdgcn_global_load_lds((const unsigned*)((const char*)(gbase) + (voff)[_i]), (LAS unsigned*)(lds + (bufoff) + ldsw + _i * 8192), 16, 0, 0); } while (0)
#define PG8_LDA(dst, b, h) do { _Pragma("unroll") for (int m = 0; m < 4; ++m) _Pragma("unroll") for (int k = 0; k < 2; ++k) dst[m][k] = *(const LAS bf16x8*)(lds + PG8_SA(b, h) + aoff + m * 2048 + k * 1024); } while (0)
#define PG8_LDB(dst, b, h) do { _Pragma("unroll") for (int n = 0; n < 2; ++n) _Pragma("unroll") for (int k = 0; k < 2; ++k) dst[n][k] = *(const LAS bf16x8*)(lds + PG8_SB(b, h) + boff + n * 2048 + k * 1024); } while (0)
#define PG8_MMA(ai, bj, At, Bt) do { __builtin_amdgcn_s_setprio(1); _Pragma("unroll") for (int m = 0; m < 4; ++m) _Pragma("unroll") for (int n = 0; n < 2; ++n) _Pragma("unroll") for (int k = 0; k < 2; ++k) \
        acc[ai][bj][m][n] = __builtin_amdgcn_mfma_f32_16x16x32_bf16(Bt[n][k], At[m][k], acc[ai][bj][m][n], 0, 0, 0); __builtin_amdgcn_s_setprio(0); } while (0)
#define PG8_WAIT_V(n) asm volatile("s_waitcnt vmcnt(" #n ")" ::: "memory")
#define PG8_WAIT_L(n) asm volatile("s_waitcnt lgkmcnt(" #n ")" ::: "memory")
#define PG8_BAR __builtin_amdgcn_s_barrier()
#define PG8_SCHED __builtin_amdgcn_sched_barrier(0)
    Unit cur, nxt; int ui = 0, relax = 0;
    if (!S.next(0, cur)) return;
    f32x4 acc[2][2][4][2];
#pragma unroll
    for (int a = 0; a < 2; ++a)
#pragma unroll
        for (int b = 0; b < 2; ++b)
#pragma unroll
            for (int m = 0; m < 4; ++m)
#pragma unroll
                for (int n = 0; n < 2; ++n) acc[a][b][m][n] = (f32x4){0.f, 0.f, 0.f, 0.f};
    bf16x8 At[4][2], B0[2][2], B1[2][2];
    const char* cA = (const char*)g.A + (size_t)cur.pm * tstepA + (cur.half > 0 ? hstepA : 0); const char* cB = (const char*)g.Bt + (size_t)cur.pn * tstepB;
    size_t chs = (cur.half < 0) ? hstepA : 0;
    if constexpr (SP2) {
        PG8_STAGE(PG8_SB(0, 0), cB, voffB); PG8_STAGE(PG8_SB(0, 1), cB + hstepB, voffB); PG8_STAGE(PG8_SA(0, 0), cA, voffA); PG8_STAGE(PG8_SA(0, 1), cA + chs, voffA);
        if (wr == 1) PG8_BAR;
        PG8_WAIT_V(2); PG8_BAR;
        PG8_STAGE(PG8_SB(1, 0), cB + kstep, voffB); PG8_STAGE(PG8_SA(1, 0), cA + kstep, voffA); PG8_STAGE(PG8_SB(1, 1), cB + hstepB + kstep, voffB);
        PG8_WAIT_V(6); PG8_BAR;
    } else {
        PG8_STAGE(PG8_SB(0, 0), cB, voffB); PG8_STAGE(PG8_SA(0, 0), cA, voffA); PG8_STAGE(PG8_SB(0, 1), cB + hstepB, voffB); PG8_STAGE(PG8_SA(0, 1), cA + chs, voffA);
        if (wr == 1) PG8_BAR;
        PG8_WAIT_V(4); PG8_BAR;
        PG8_STAGE(PG8_SB(1, 0), cB + kstep, voffB); PG8_STAGE(PG8_SA(1, 0), cA + kstep, voffA); PG8_STAGE(PG8_SB(1, 1), cB + hstepB + kstep, voffB);
        PG8_WAIT_V(6); PG8_BAR;
    }
    for (;;) {
        const bool has_next = S.next(ui + 1, nxt);
        const char* nA = has_next ? (const char*)g.A + (size_t)nxt.pm * tstepA + (nxt.half > 0 ? hstepA : 0) : cA; const char* nB = has_next ? (const char*)g.Bt + (size_t)nxt.pn * tstepB : cB;
        const size_t nhs = has_next ? ((nxt.half < 0) ? hstepA : 0) : chs;
        const bool full = cur.half < 0;
        for (int t = 0; t < nt; t += 2) {
            const bool last = (t == nt - 2);
            const char* a1 = cA + (size_t)(t + 1) * kstep;
            const char* a2 = last ? nA : cA + (size_t)(t + 2) * kstep; const char* b2 = last ? nB : cB + (size_t)(t + 2) * kstep;
            const char* a3 = a2 + kstep; const char* b3 = b2 + kstep;
            const size_t h2 = last ? nhs : chs;
            if constexpr (SP2) {
            int rel = __builtin_amdgcn_readfirstlane(relax); asm volatile("" : "+s"(rel));
#define PG8_WAIT_V8R() asm volatile("s_cmp_lt_i32 %0, 16\n\ts_cbranch_scc1 1f\n\ts_waitcnt vmcnt(24)\n\ts_branch 2f\n1:\n\ts_waitcnt vmcnt(8)\n2:" :: "s"(rel) : "memory", "scc")
            PG8_LDB(B0, 0, 0); PG8_LDB(B1, 0, 1); PG8_SCHED; PG8_LDA(At, 0, 0); PG8_STAGE(PG8_SA(1, 1), a1 + chs, voffA);
            PG8_WAIT_V8R(); PG8_WAIT_L(0); PG8_BAR; PG8_MMA(0, 0, At, B0); PG8_MMA(0, 1, At, B1); PG8_BAR; PG8_SCHED;
            if (full) PG8_LDA(At, 0, 1); PG8_STAGE(PG8_SB(0, 0), b2, voffB); PG8_STAGE(PG8_SB(0, 1), b2 + hstepB, voffB); PG8_STAGE(PG8_SA(0, 0), a2, voffA);
            PG8_WAIT_V8R(); PG8_WAIT_L(0); PG8_BAR; if (full) { PG8_MMA(1, 0, At, B0); PG8_MMA(1, 1, At, B1); } PG8_BAR; PG8_SCHED;
#undef PG8_WAIT_V8R
            PG8_LDB(B0, 1, 0); PG8_LDB(B1, 1, 1); PG8_SCHED; PG8_LDA(At, 1, 0); PG8_STAGE(PG8_SA(0, 1), a2 + h2, voffA);
            PG8_WAIT_V(8); PG8_WAIT_L(0); PG8_BAR; PG8_MMA(0, 0, At, B0); PG8_MMA(0, 1, At, B1); PG8_BAR; PG8_SCHED;
            if (full) PG8_LDA(At, 1, 1); PG8_STAGE(PG8_SB(1, 0), b3, voffB); PG8_STAGE(PG8_SB(1, 1), b3 + hstepB, voffB); PG8_STAGE(PG8_SA(1, 0), a3, voffA);
            PG8_WAIT_V(8); PG8_WAIT_L(0); PG8_BAR; if (full) { PG8_MMA(1, 0, At, B0); PG8_MMA(1, 1, At, B1); } PG8_BAR; PG8_SCHED;
            relax = 0; asm volatile("" : "+s"(relax));
            } else {
            static_assert(SP2, "the four-phase loop has no half-unit support");
            PG8_LDB(B0, 0, 0); PG8_SCHED; PG8_LDA(At, 0, 0); PG8_STAGE(PG8_SA(1, 1), a1 + hstepA, voffA);
            PG8_WAIT_L(8); PG8_BAR; PG8_WAIT_L(0); PG8_MMA(0, 0, At, B0); PG8_BAR; PG8_SCHED;
            PG8_LDB(B1, 0, 1); PG8_STAGE(PG8_SB(0, 0), b2, voffB);
            PG8_BAR; PG8_WAIT_L(0); PG8_MMA(0, 1, At, B1); PG8_BAR;
            PG8_LDA(At, 0, 1); PG8_STAGE(PG8_SA(0, 0), a2, voffA);
            PG8_BAR; PG8_WAIT_L(0); PG8_MMA(1, 0, At, B0); PG8_BAR; PG8_SCHED;
            PG8_STAGE(PG8_SB(0, 1), b2 + hstepB, voffB);
            PG8_WAIT_V(6); PG8_BAR; PG8_MMA(1, 1, At, B1); PG8_BAR;
            PG8_LDB(B0, 1, 0); PG8_SCHED; PG8_LDA(At, 1, 0); PG8_STAGE(PG8_SA(0, 1), a2 + hstepA, voffA);
            PG8_WAIT_L(8); PG8_BAR; PG8_WAIT_L(0); PG8_MMA(0, 0, At, B0); PG8_BAR; PG8_SCHED;
            PG8_LDB(B1, 1, 1); PG8_STAGE(PG8_SB(1, 0), b3, voffB);
            PG8_BAR; PG8_WAIT_L(0); PG8_MMA(0, 1, At, B1); PG8_BAR;
            PG8_LDA(At, 1, 1); PG8_STAGE(PG8_SA(1, 0), a3, voffA);
            PG8_BAR; PG8_WAIT_L(0); PG8_MMA(1, 0, At, B0); PG8_BAR; PG8_SCHED;
            PG8_STAGE(PG8_SB(1, 1), b3 + hstepB, voffB);
            PG8_WAIT_V(6); PG8_BAR; PG8_MMA(1, 1, At, B1); PG8_BAR;
            }
        }
        if constexpr (ALIGN_EPI) { if (wr == 0) PG8_BAR; }
        E(acc, cur, wr, wc, fr, fq, xb, lane);
#if EPI_TWICE
        asm volatile("" ::: "memory"); E(acc, cur, wr, wc, fr, fq, xb, lane);
#endif
        if (!has_next) break;
#pragma unroll
        for (int a = 0; a < 2; ++a)
#pragma unroll
            for (int b = 0; b < 2; ++b)
#pragma unroll
                for (int m = 0; m < 4; ++m)
#pragma unroll
                    for (int n = 0; n < 2; ++n) acc[a][b][m][n] = (f32x4){0.f, 0.f, 0.f, 0.f};
        relax = Epi::nstores(cur);
        cur = nxt; cA = nA; cB = nB; chs = nhs; ++ui;
        if constexpr (ALIGN_EPI) { if (wr == 1) PG8_BAR; }
    }
    PG8_WAIT_V(0);
    if constexpr (!ALIGN_EPI) { if (wr == 0) PG8_BAR; }
    PG8_BAR;
#undef PG8_SA
#undef PG8_SB
#undef PG8_STAGE
#undef PG8_LDA
#undef PG8_LDB
#undef PG8_MMA
#undef PG8_WAIT_V
#undef PG8_WAIT_L
#undef PG8_BAR
#undef PG8_SCHED
}
}

namespace att {
constexpr int D = 128, NW = 8, QBLK = 32, KVBLK = 64;
constexpr float SCALE = 0.088388347648318440f;
constexpr float THR = 8.f;
constexpr int LDQ = DM, LDK = KVW, LDO = DM;
constexpr size_t SHM_V = KVBLK * D * 2, SHM_K = KVBLK * D * 2, SHM_ATTN = 2 * SHM_V + 2 * SHM_K + NW * 64 * 4;
#define KSWZ(row, colB) ((row) * 256 + ((colB) ^ (((row) & 7) << 4)))
#define SBAR() __builtin_amdgcn_sched_barrier(0)
__device__ __forceinline__ int crow(int r, int hi) { return (r & 3) + 8 * (r >> 2) + 4 * hi; }
__device__ __forceinline__ unsigned cvtpk(float lo, float hi) { unsigned r; asm volatile("v_cvt_pk_bf16_f32 %0, %1, %2" : "=v"(r) : "v"(lo), "v"(hi)); return r; }
__device__ __forceinline__ bf16x8 ld8(const bf16_t* p) { return *reinterpret_cast<const bf16x8*>(p); }

__device__ __forceinline__ void partialSM(f32x16& p0, f32x16& p1, float& m_reg, float& mn, float& alpha) {
  constexpr float C = SCALE * 1.4426950408889634f;
  float pmax = p0[0];
#pragma unroll
  for (int r = 1; r < 16; ++r) pmax = fmaxf(pmax, p0[r]);
#pragma unroll
  for (int r = 0; r < 16; ++r) pmax = fmaxf(pmax, p1[r]);
  { auto rr = __builtin_amdgcn_permlane32_swap(__float_as_uint(pmax), __float_as_uint(pmax), false, false);
    pmax = fmaxf(__uint_as_float(rr[0]), __uint_as_float(rr[1])); }
  if (__builtin_expect(__all(pmax - m_reg <= THR / SCALE), 1)) { mn = m_reg; alpha = 1.f; }
  else { mn = fmaxf(m_reg, pmax); alpha = __builtin_amdgcn_exp2f((m_reg - mn) * C); m_reg = mn; }
  float mnC = -mn * C;
#pragma unroll
  for (int r = 0; r < 16; ++r) p0[r] = fmaf(p0[r], C, mnC);
#pragma unroll
  for (int r = 0; r < 16; ++r) p1[r] = fmaf(p1[r], C, mnC);
#pragma unroll
  for (int r = 0; r < 16; ++r) p0[r] = __builtin_amdgcn_exp2f(p0[r]);
}
__device__ __forceinline__ void finishSM(f32x16& p0, f32x16& p1, float alpha, float& l_reg, bf16x8& pa0, bf16x8& pa1, bf16x8& pa2, bf16x8& pa3) {
#pragma unroll
  for (int r = 0; r < 16; ++r) p1[r] = __builtin_amdgcn_exp2f(p1[r]);
  float ps = 0;
#pragma unroll
  for (int r = 0; r < 16; ++r) ps += p0[r];
#pragma unroll
  for (int r = 0; r < 16; ++r) ps += p1[r];
  { auto rr = __builtin_amdgcn_permlane32_swap(__float_as_uint(ps), __float_as_uint(ps), false, false);
    ps = __uint_as_float(rr[0]) + __uint_as_float(rr[1]); }
  l_reg = l_reg * alpha + ps;
#define PK4(P, BASE, OUT) do { unsigned a0 = cvtpk(P[BASE + 0], P[BASE + 1]), a1 = cvtpk(P[BASE + 2], P[BASE + 3]);   \
    unsigned b0 = cvtpk(P[BASE + 4], P[BASE + 5]), b1 = cvtpk(P[BASE + 6], P[BASE + 7]);                              \
    auto r0 = __builtin_amdgcn_permlane32_swap(a0, b0, false, false); auto r1 = __builtin_amdgcn_permlane32_swap(a1, b1, false, false); \
    u32x4 w = {r0[0], r1[0], r0[1], r1[1]}; OUT = *reinterpret_cast<bf16x8*>(&w); } while (0)
  PK4(p0, 0, pa0); PK4(p0, 8, pa1); PK4(p1, 0, pa2); PK4(p1, 8, pa3);
#undef PK4
}
__device__ __forceinline__ void qkt(f32x16& p0, f32x16& p1, const bf16_t* Ks, const bf16x8* qr, int r32, int hi) {
  p0 = f32x16{}; p1 = f32x16{};
#pragma unroll
  for (int d0 = 0; d0 < 8; ++d0) { int cb = (d0 * 16 + hi * 8) * 2;
    bf16x8 b0 = *reinterpret_cast<const bf16x8*>((const char*)Ks + KSWZ(r32, cb));
    bf16x8 b1 = *reinterpret_cast<const bf16x8*>((const char*)Ks + KSWZ(32 + r32, cb));
    p0 = __builtin_amdgcn_mfma_f32_32x32x16_bf16(b0, qr[d0], p0, 0, 0, 0);
    p1 = __builtin_amdgcn_mfma_f32_32x32x16_bf16(b1, qr[d0], p1, 0, 0, 0); }
}
__device__ __forceinline__ int v_st(int k, int c) { const int kk = (k & ~0xC) | ((k & 4) << 1) | ((k & 8) >> 1); return ((kk >> 3) * 4 + (c >> 5)) * 512 + ((kk & 7) * 32 + (c & 31)) * 2; }
__device__ __forceinline__ int v_rd_base(int lane) { return ((lane & 3) << 3) | (((lane >> 2) & 3) << 6) | (((lane >> 4) & 1) << 5) | (((lane >> 5) & 1) << 8); }
constexpr int v_rd_off(int d0, int ks, int half) { return d0 * 512 + ks * 4096 + half * 2048; }
template <int OFF> __device__ __forceinline__ s16x4 tr_read(int vb) {
  s16x4 r; asm volatile("ds_read_b64_tr_b16 %0, %1 offset:%2" : "=&v"(r) : "v"(vb), "i"(OFF) : "memory"); return r;
}
template <int D0> __device__ __forceinline__ void pv_one(f32x16& od, int vb, bf16x8 pa0, bf16x8 pa1, bf16x8 pa2, bf16x8 pa3) {
  const s16x4 l0 = tr_read<v_rd_off(D0, 0, 0)>(vb), h0 = tr_read<v_rd_off(D0, 0, 1)>(vb), l1 = tr_read<v_rd_off(D0, 1, 0)>(vb), h1 = tr_read<v_rd_off(D0, 1, 1)>(vb);
  const s16x4 l2 = tr_read<v_rd_off(D0, 2, 0)>(vb), h2 = tr_read<v_rd_off(D0, 2, 1)>(vb), l3 = tr_read<v_rd_off(D0, 3, 0)>(vb), h3 = tr_read<v_rd_off(D0, 3, 1)>(vb);
  asm volatile("s_waitcnt lgkmcnt(0)" ::: "memory"); SBAR();
#define PK(L, H) (bf16x8){L[0], L[1], L[2], L[3], H[0], H[1], H[2], H[3]}
  od = __builtin_amdgcn_mfma_f32_32x32x16_bf16(pa0, PK(l0, h0), od, 0, 0, 0);
  od = __builtin_amdgcn_mfma_f32_32x32x16_bf16(pa1, PK(l1, h1), od, 0, 0, 0);
  od = __builtin_amdgcn_mfma_f32_32x32x16_bf16(pa2, PK(l2, h2), od, 0, 0, 0);
  od = __builtin_amdgcn_mfma_f32_32x32x16_bf16(pa3, PK(l3, h3), od, 0, 0, 0);
#undef PK
}
__device__ __forceinline__ void pv_d0(f32x16* o, int vb, bf16x8 pa0, bf16x8 pa1, bf16x8 pa2, bf16x8 pa3) {
  pv_one<0>(o[0], vb, pa0, pa1, pa2, pa3); pv_one<1>(o[1], vb, pa0, pa1, pa2, pa3); pv_one<2>(o[2], vb, pa0, pa1, pa2, pa3); pv_one<3>(o[3], vb, pa0, pa1, pa2, pa3);
}

__device__ __forceinline__ void attn_dense_body(const bf16_t* __restrict__ Qb, const bf16_t* __restrict__ Kh, const bf16_t* __restrict__ Vh,
                                                bf16_t* __restrict__ Ob, int seq, char* lds, const int tid) {
  const int wid = tid >> 6, lane = tid & 63, r32 = lane & 31, hi = lane >> 5;
  bf16_t* V_lds = (bf16_t*)lds; bf16_t* K_lds = (bf16_t*)(lds + 2 * SHM_V);
  float* ws = (float*)(lds + 2 * SHM_V + 2 * SHM_K) + wid * 64; float* li_l = ws; float* al_l = ws + 32;
  float m_reg = -1e30f, l_reg = 0; f32x16 o[4] = {}; bf16x8 qr[8];
  const bf16_t* Qw = Qb + (long)(wid * QBLK + r32) * LDQ + hi * 8;
#pragma unroll
  for (int d0 = 0; d0 < 8; ++d0) qr[d0] = ld8(Qw + d0 * 16);
  const int sr = tid >> 4, sc = (tid & 15) * 8, vst0 = v_st(sr, sc), vst1 = v_st(32 + sr, sc);
  const int vb0 = (int)(uintptr_t)V_lds + v_rd_base(lane);
  struct { bf16x8 vs0, vs1, ks0, ks1; } sr_[2];
#define SLOAD(i, k0) do { sr_[i].vs0 = ld8(&Vh[(long)((k0) + sr) * LDK + sc]); sr_[i].vs1 = ld8(&Vh[(long)((k0) + 32 + sr) * LDK + sc]); \
    sr_[i].ks0 = ld8(&Kh[(long)((k0) + sr) * LDK + sc]); sr_[i].ks1 = ld8(&Kh[(long)((k0) + 32 + sr) * LDK + sc]); } while (0)
#define SWRITE(b, i) do { *(bf16x8*)((char*)V_lds + (b) * SHM_V + vst0) = sr_[i].vs0;          \
    *(bf16x8*)((char*)V_lds + (b) * SHM_V + vst1) = sr_[i].vs1; int kc = sc * 2;               \
    *(bf16x8*)((char*)K_lds + (b) * SHM_K + KSWZ(sr, kc)) = sr_[i].ks0;                       \
    *(bf16x8*)((char*)K_lds + (b) * SHM_K + KSWZ(32 + sr, kc)) = sr_[i].ks1; } while (0)
#define SWAIT() asm volatile("s_waitcnt vmcnt(4)" ::: "memory")
#define RESC(a) do { if (__any((a) < 1.f)) { if (hi == 0) al_l[r32] = (a); asm volatile("s_waitcnt lgkmcnt(0)" ::: "memory"); \
    _Pragma("unroll") for (int d = 0; d < 4; ++d) _Pragma("unroll") for (int r = 0; r < 16; ++r) o[d][r] *= al_l[crow(r, hi)]; } } while (0)
  f32x16 pA0, pA1, pB0, pB1; float mnA, mnB, alA, alB; bf16x8 pa0, pa1, pa2, pa3; const int NT = seq / KVBLK;
  constexpr int SE = 0, SO = 1;
  SLOAD(SE, 0); asm volatile("s_waitcnt vmcnt(0)" ::: "memory"); SWRITE(0, SE); __syncthreads();
  qkt(pA0, pA1, K_lds, qr, r32, hi); partialSM(pA0, pA1, m_reg, mnA, alA);
  SLOAD(SO, KVBLK); if (2 < NT) SLOAD(SE, 2 * KVBLK);
  SWAIT(); SWRITE(1, SO); __syncthreads();
  for (int j = 1; j + 1 < NT; j += 2) {
    SBAR(); qkt(pB0, pB1, (bf16_t*)((char*)K_lds + SHM_K), qr, r32, hi);
    finishSM(pA0, pA1, alA, l_reg, pa0, pa1, pa2, pa3); SBAR();
    SLOAD(SO, (j + 2) * KVBLK); SBAR();
    pv_d0(o, vb0, pa0, pa1, pa2, pa3); partialSM(pB0, pB1, m_reg, mnB, alB);
    __syncthreads(); SWAIT(); SWRITE(0, SE);
    RESC(alB); __syncthreads();
    SBAR(); qkt(pA0, pA1, K_lds, qr, r32, hi);
    finishSM(pB0, pB1, alB, l_reg, pa0, pa1, pa2, pa3); SBAR();
    if (j + 3 < NT) SLOAD(SE, (j + 3) * KVBLK); SBAR();
    pv_d0(o, vb0 + (int)SHM_V, pa0, pa1, pa2, pa3); partialSM(pA0, pA1, m_reg, mnA, alA);
    __syncthreads(); SWAIT(); SWRITE(1, SO);
    RESC(alA); __syncthreads();
  }
  SBAR(); qkt(pB0, pB1, (bf16_t*)((char*)K_lds + SHM_K), qr, r32, hi);
  finishSM(pA0, pA1, alA, l_reg, pa0, pa1, pa2, pa3); SBAR();
  pv_d0(o, vb0, pa0, pa1, pa2, pa3); partialSM(pB0, pB1, m_reg, mnB, alB);
  __syncthreads(); RESC(alB);
  finishSM(pB0, pB1, alB, l_reg, pa0, pa1, pa2, pa3); SBAR();
  pv_d0(o, vb0 + (int)SHM_V, pa0, pa1, pa2, pa3);
  if (hi == 0) li_l[r32] = l_reg; asm volatile("s_waitcnt lgkmcnt(0)" ::: "memory");
  float rli[16];
#pragma unroll
  for (int r = 0; r < 16; ++r) rli[r] = __builtin_amdgcn_rcpf(li_l[crow(r, hi)]);
  bf16_t* Ow = Ob + (long)(wid * QBLK) * LDO;
#pragma unroll
  for (int r = 0; r < 16; ++r) { int orow = crow(r, hi);
#pragma unroll
    for (int d0 = 0; d0 < 4; ++d0) Ow[(long)orow * LDO + d0 * 32 + r32] = (bf16_t)f2bf(o[d0][r] * rli[r]); }
#undef SLOAD
#undef SWRITE
#undef SWAIT
#undef RESC
}
#undef KSWZ
#undef SBAR
}

#define XB_TMO      128
#define XB_XCNT(j)  (256  + 64 * (j))
#define XB_XSUB(j)  (1280 + 64 * (j))
#define XB_XGEN(j)  (2304 + 64 * (j))
#define XB_TOP      3328
#define XB_TOPGEN   3392
#define XCD_BAR_WORDS 3456
#define XB_SPIN_CAP (1u << 18)
__device__ __forceinline__ unsigned xb_ld(unsigned* p)              { return __hip_atomic_load(p, __ATOMIC_RELAXED, __HIP_MEMORY_SCOPE_AGENT); }
__device__ __forceinline__ unsigned xb_add(unsigned* p, unsigned v) { return __hip_atomic_fetch_add(p, v, __ATOMIC_RELAXED, __HIP_MEMORY_SCOPE_AGENT); }
__device__ __forceinline__ unsigned xb_xcc_id() { return (unsigned)__builtin_amdgcn_s_getreg((3 << 11) | 20) & 0xFu; }
#define XB_SPIN(cond, bar) do { unsigned _sp = 0; while (cond) { __builtin_amdgcn_s_sleep(1); \
    if ((++_sp & 255u) == 0u) { if (xb_ld(&(bar)[XB_TMO])) break; if (_sp > XB_SPIN_CAP) { atomicAdd(&(bar)[XB_TMO], 1u); break; } } } } while (0)
struct XcdBarrier { unsigned* bar; unsigned x; volatile LAS unsigned* st; };
__device__ __forceinline__ XcdBarrier xcd_barrier_post(unsigned* bar, volatile LAS unsigned* st) {
    XcdBarrier b; b.bar = bar; b.x = xb_xcc_id(); b.st = st;
    if (threadIdx.x == 0) (void)xb_add(&bar[XB_XCNT(b.x)], 1u);
    return b;
}
__device__ __forceinline__ void xcd_barrier_complete(unsigned* bar, unsigned x, unsigned& nloc, unsigned& nx) {
    const unsigned G = gridDim.x * gridDim.y * gridDim.z;
    unsigned sum, cnt, mine, sp = 0u;
    for (;;) {
        sum = 0u; cnt = 0u; mine = 0u;
#pragma unroll
        for (unsigned j = 0; j < 16; ++j) { const unsigned c = xb_ld(&bar[XB_XCNT(j)]); sum += c; cnt += (c > 0u) ? 1u : 0u; mine = (j == x) ? c : mine; }
        if (sum == G) break;
        __builtin_amdgcn_s_sleep(1);
        if ((++sp & 255u) == 0u) { if (xb_ld(&bar[XB_TMO])) break; if (sp > XB_SPIN_CAP) { atomicAdd(&bar[XB_TMO], 1u); break; } }
    }
    nloc = mine > 0u ? mine : 1u; nx = cnt > 0u ? cnt : 1u;
}
__device__ __forceinline__ void xcd_barrier(const XcdBarrier& b) {
    asm volatile("s_waitcnt vmcnt(0)" ::: "memory");
    __syncthreads();
    if (threadIdx.x == 0) {
        unsigned* bar = b.bar;
        __builtin_amdgcn_s_waitcnt(0);
        unsigned nloc = b.st[0], nx = b.st[1];
        if (nloc == 0u) { xcd_barrier_complete(bar, b.x, nloc, nx); b.st[0] = nloc; b.st[1] = nx; }
        const unsigned old = xb_add(&bar[XB_XSUB(b.x)], 1u);
        const unsigned gen = old / nloc;
        if (old + 1u == (gen + 1u) * nloc) {
            __builtin_amdgcn_fence(__ATOMIC_RELEASE, "agent");
            asm volatile("s_waitcnt vmcnt(0)" ::: "memory");
            const unsigned og = xb_add(&bar[XB_TOP], 1u);
            const unsigned tg = og / nx;
            if (og + 1u == (tg + 1u) * nx) xb_add(&bar[XB_TOPGEN], 1u);
            else XB_SPIN(xb_ld(&bar[XB_TOPGEN]) == tg, bar);
            __builtin_amdgcn_fence(__ATOMIC_ACQUIRE, "agent");
            xb_add(&bar[XB_XGEN(b.x)], 1u);
            asm volatile("s_waitcnt vmcnt(0)" ::: "memory");
        } else {
            XB_SPIN(xb_ld(&bar[XB_XGEN(b.x)]) == gen, bar);
            __builtin_amdgcn_fence(__ATOMIC_ACQUIRE, "agent");
            asm volatile("s_waitcnt vmcnt(0)" ::: "memory");
        }
    }
    __syncthreads();
}

struct Args {
    const float* in[22]; float* out; unsigned char* ws; int ph_lo, ph_hi;
};
struct Frame {
    LAS unsigned char* lds; unsigned char* ws;
    int tid, lane, wave, vcu, G;
};

struct TrItem { const float* W; bf16_t* WT; int N, ldk, dest_row0, k0, n0; };
__device__ __forceinline__ void tr_load(const TrItem& t, f32x4 (&v)[8], int lane) {
    const int r = lane >> 3, c4 = lane & 7;
#pragma unroll
    for (int i = 0; i < 8; ++i) v[i] = *(const f32x4*)(t.W + (size_t)(t.k0 + 8 * i + r) * t.N + t.n0 + 4 * c4);
}
__device__ __forceinline__ void tr_finish(const TrItem& t, const f32x4 (&v)[8], LAS float* scr, int lane) {
    const int r = lane >> 3, c4 = lane & 7;
#pragma unroll
    for (int i = 0; i < 8; ++i)
#pragma unroll
        for (int q = 0; q < 4; ++q) scr[(4 * c4 + q) * 65 + 8 * i + r] = v[i][q];
    LDS_WAIT(); asm volatile("" ::: "memory");
    const int c = lane & 7;
#pragma unroll
    for (int j = 0; j < 4; ++j) { const int n = (lane >> 3) + 8 * j; const LAS float* s = scr + n * 65 + 8 * c;
        u32x4 o; o.x = pk2(s[0], s[1]); o.y = pk2(s[2], s[3]); o.z = pk2(s[4], s[5]); o.w = pk2(s[6], s[7]);
        *(u32x4*)(t.WT + (size_t)(t.dest_row0 + n) * t.ldk + t.k0 + 8 * c) = o; }
    LDS_WAIT(); asm volatile("" ::: "memory");
}

__device__ __forceinline__ void load16(const float* p, int lane, float (&v)[16]) {
    const f32x4 a = *(const f32x4*)(p + 8 * lane), b = *(const f32x4*)(p + 8 * lane + 4), c = *(const f32x4*)(p + 512 + 8 * lane), d = *(const f32x4*)(p + 512 + 8 * lane + 4);
#pragma unroll
    for (int j = 0; j < 4; ++j) { v[j] = a[j]; v[4 + j] = b[j]; v[8 + j] = c[j]; v[12 + j] = d[j]; }
}
__device__ __forceinline__ void store16f(float* p, int lane, const float (&v)[16]) {
    *(f32x4*)(p + 8 * lane) = (f32x4){v[0], v[1], v[2], v[3]}; *(f32x4*)(p + 8 * lane + 4) = (f32x4){v[4], v[5], v[6], v[7]};
    *(f32x4*)(p + 512 + 8 * lane) = (f32x4){v[8], v[9], v[10], v[11]}; *(f32x4*)(p + 512 + 8 * lane + 4) = (f32x4){v[12], v[13], v[14], v[15]};
}
__device__ __forceinline__ void load16bf(const bf16_t* p, int lane, float (&v)[16]) {
    const u32x4 a = *(const u32x4*)(p + 8 * lane), b = *(const u32x4*)(p + 512 + 8 * lane);
#pragma unroll
    for (int j = 0; j < 4; ++j) { v[2 * j] = bflo(a[j]); v[2 * j + 1] = bfhi(a[j]); v[8 + 2 * j] = bflo(b[j]); v[8 + 2 * j + 1] = bfhi(b[j]); }
}
__device__ __forceinline__ void store16bf(bf16_t* p, int lane, const float (&v)[16]) {
    u32x4 a, b;
#pragma unroll
    for (int j = 0; j < 4; ++j) { a[j] = pk2(v[2 * j], v[2 * j + 1]); b[j] = pk2(v[8 + 2 * j], v[8 + 2 * j + 1]); }
    *(u32x4*)(p + 8 * lane) = a; *(u32x4*)(p + 512 + 8 * lane) = b;
}
__device__ __forceinline__ float sumsq16(const float (&v)[16]) { float s = 0.f;
#pragma unroll
    for (int j = 0; j < 16; ++j) s = fmaf(v[j], v[j], s);
    return s; }

constexpr int HB_LD = 2 * DM;
template <int MODE, bool FIRST>
__device__ __forceinline__ void row_pass(const Frame& F, const float* x_ctx, const float* x_lat, bf16_t* hb, float* outf, const bf16_t* Y, bf16_t* XN,
                                         const float* gpost, const float* gate_mod, const float* gpre, const float* shift_mod, const float* scale_mod) {
    const int gw = F.vcu * 8 + F.wave, lane = F.lane;
    constexpr int RPW = 12;
    float pg[16], gt[16], ng[16], sc[16], sh[16];
    if (MODE != 0) load16(gpost, lane, pg);
    if (MODE != 2) load16(gpre, lane, ng);
    int curb = -1;
    for (int ch = gw; ch < T_ALL / RPW; ch += F.G * 8)
    for (int r = ch * RPW; r < ch * RPW + RPW; ++r) {
        const int b = (r < T_CTX) ? 8 : (r - T_CTX) / SEQ_L;
        if (b != curb) { curb = b;
            if (MODE != 0) load16(gate_mod + (size_t)b * NMOD, lane, gt);
            if (MODE != 2) { load16(scale_mod + (size_t)b * NMOD, lane, sc); load16(shift_mod + (size_t)b * NMOD, lane, sh);
#pragma unroll
                for (int j = 0; j < 16; ++j) sc[j] = (1.0f + sc[j]) * ng[j]; } }
        float h[16];
        if (MODE == 0 || FIRST) { const float* hp = (r < T_CTX) ? x_ctx + (size_t)r * DM : x_lat + (size_t)(r - T_CTX) * DM; load16(hp, lane, h); }
        else load16bf(hb + (size_t)r * HB_LD, lane, h);
        if (MODE != 0) {
            float y[16]; load16bf(Y + (size_t)r * DM, lane, y);
            const float rs = __builtin_amdgcn_rsqf(wave_sum(sumsq16(y)) * (1.0f / DM) + EPS);
#pragma unroll
            for (int j = 0; j < 16; ++j) h[j] = fmaf(gt[j], y[j] * rs * pg[j], h[j]);
            if (MODE == 1) store16bf(hb + (size_t)r * HB_LD, lane, h); else store16f(outf + (size_t)r * DM, lane, h);
        }
        if (MODE != 2) {
            const float rs = __builtin_amdgcn_rsqf(wave_sum(sumsq16(h)) * (1.0f / DM) + EPS);
            float x[16];
#pragma unroll
            for (int j = 0; j < 16; ++j) x[j] = fmaf(h[j] * rs, sc[j], sh[j]);
            store16bf(XN + (size_t)r * DM, lane, x);
        }
    }
}

__device__ __forceinline__ void sincos_d(double x, double& s, double& c) {
    const double k = __builtin_rint(x * 0.63661977236758134308);
    const double r = fma(-k, 6.123233995736766036e-17, fma(-k, 1.57079632679489655800, x));
    const double r2 = r * r;
    double sp = -7.647163731819816476e-13; sp = fma(sp, r2, 1.605904383682161460e-10); sp = fma(sp, r2, -2.505210838544171878e-08); sp = fma(sp, r2, 2.755731922398589065e-06);
    sp = fma(sp, r2, -1.984126984126984127e-04); sp = fma(sp, r2, 8.333333333333333333e-03); sp = fma(sp, r2, -1.666666666666666667e-01); sp = fma(sp * r2, r, r);
    double cp = 4.779477332387385297e-14; cp = fma(cp, r2, -1.147074559772972471e-11); cp = fma(cp, r2, 2.087675698786809898e-09); cp = fma(cp, r2, -2.755731922398589065e-07);
    cp = fma(cp, r2, 2.480158730158730159e-05); cp = fma(cp, r2, -1.388888888888888889e-03); cp = fma(cp, r2, 4.166666666666666667e-02); cp = fma(cp, r2, -0.5); cp = fma(cp, r2, 1.0);
    const int q = ((int)k) & 3;
    s = (q == 0) ? sp : (q == 1) ? cp : (q == 2) ? -sp : -cp;
    c = (q == 0) ? cp : (q == 1) ? -sp : (q == 2) ? -cp : sp;
}

constexpr int N_PHASES = 19;
__device__ __forceinline__ const float* kin_ptr(int i) {
    typedef __attribute__((address_space(4))) const char* kptr_t;
    kptr_t kp = (kptr_t)__builtin_amdgcn_kernarg_segment_ptr();
    asm volatile("" : "+s"(kp));
    typedef const float* fptr_t; typedef __attribute__((address_space(4))) const fptr_t* kfp_t;
    return *(kfp_t)(kp + 8 * i);
}

__global__ void __launch_bounds__(512, 2) mega_fwd(Args args) {
    extern __shared__ __attribute__((aligned(16))) unsigned char lds_raw[];
    Frame F;
    F.lds = (LAS unsigned char*)lds_raw; F.ws = args.ws;
    F.tid = threadIdx.x; F.lane = F.tid & 63; F.wave = __builtin_amdgcn_readfirstlane(F.tid >> 6);
    F.G = gridDim.x; { const int bx = blockIdx.x; F.vcu = (F.G % 8 == 0) ? (bx % 8) * (F.G / 8) + bx / 8 : bx; }
    unsigned char* ws = args.ws;
    unsigned* ctl = (unsigned*)(ws + WS_CTL);
    volatile LAS unsigned* MISC = (volatile LAS unsigned*)(F.lds + MISC_OFF);
    for (int u = F.tid; u < (LDS_BYTES - LDSCTL_OFF) / 4; u += 512) ((LAS unsigned*)(F.lds + LDSCTL_OFF))[u] = 0u;
    __syncthreads();
    XcdBarrier bar; bar.bar = ctl + CW_BAR; bar.x = 0; bar.st = nullptr;
#if MK_N_LAUNCHES == 1
    constexpr int lo = 0, hi = N_PHASES;
#else
    const int lo = args.ph_lo, hi = args.ph_hi;
#endif
    if (hi - lo > 1) bar = xcd_barrier_post(ctl + CW_BAR, MISC + 8);
#ifndef PH_MASK
#define PH_MASK 0x7ffff
#endif
#define IN(k) (((PH_MASK >> (k)) & 1) && lo <= (k) && (k) < hi)
#if PROBE_MASK
    unsigned long long pr_t0 = __builtin_amdgcn_s_memrealtime();
#define PROBE_END(k) do { if ((PROBE_MASK >> (k)) & 1) { const unsigned long long _t1 = __builtin_amdgcn_s_memrealtime(); const unsigned long long _d = _t1 - pr_t0; \
        while (__builtin_amdgcn_s_memrealtime() - _t1 < _d) __builtin_amdgcn_s_sleep(8); } } while (0)
#define PROBE_T0() pr_t0 = __builtin_amdgcn_s_memrealtime()
#else
#define PROBE_END(k) do { } while (0)
#define PROBE_T0() do { } while (0)
#endif
#define SEAM(k) do { PROBE_END(k); if (IN(k) && IN((k) + 1)) xcd_barrier(bar); PROBE_T0(); } while (0)

#define KIN(i) kin_ptr(i)
#define PH_BEGIN() do { int _t = threadIdx.x; asm volatile("" : "+v"(_t)); F.tid = _t; F.lane = _t & 63; } while (0)
    float* H = args.out;
    bf16_t* HB = (bf16_t*)args.out;
    float* new_k = args.out + (size_t)T_ALL * DM; float* new_v = new_k + (size_t)T_CTX * KVW;
    float* MOD = (float*)(ws + WS_MOD); float* ROPE = (float*)(ws + WS_ROPE); float* RAWB = (float*)(ws + WS_RAWB);
    bf16_t* Win_t = (bf16_t*)(ws + WS_WIN); bf16_t* Wout_t = (bf16_t*)(ws + WS_WOUT); bf16_t* Wqkv_t = (bf16_t*)(ws + WS_WQKV); bf16_t* Wo_t = (bf16_t*)(ws + WS_WO);
    bf16_t* Wup_t = (bf16_t*)(ws + WS_WUP); bf16_t* Wdn_t = (bf16_t*)(ws + WS_WDN);
    bf16_t* XN = (bf16_t*)(ws + WS_XN);
    unsigned char* big = ws + WS_BIG;
    bf16_t* CV = (bf16_t*)(big + BIG_CV); bf16_t* A2 = (bf16_t*)(big + BIG_A2); bf16_t* QKV = (bf16_t*)(big + BIG_QKV); bf16_t* OB = (bf16_t*)(big + BIG_O);
    bf16_t* QB = (bf16_t*)(big + BIG_Q); bf16_t* KALL = (bf16_t*)(big + BIG_KALL); bf16_t* VALL = (bf16_t*)(big + BIG_VALL); bf16_t* KC = (bf16_t*)(big + BIG_KC); bf16_t* VC = (bf16_t*)(big + BIG_VC);
    LAS unsigned char* ring = F.lds; LAS unsigned char* xbuf = F.lds + XB_OFF;
    const int gw = F.vcu * 8 + F.wave, NGW = F.G * 8;

#define PREP_GEMV(L, KR, item) do { \
        const float* const cvec = KIN(4); const float* const c_ctx = KIN(5); const float* const mod_w = KIN(6); const float* const mod_b = KIN(7); \
        LAS float* sl = (LAS float*)ring;   \
        const int cchunk = (item) & 7, kchunk = (item) >> 3, k0 = kchunk * (KR); \
        __syncthreads(); \
        for (int e = F.tid; e < 9 * (KR); e += 512) { const int r = e / (KR), k = e % (KR); const float v = (r < 8) ? cvec[r * DM + k0 + k] : c_ctx[k0 + k]; sl[r * 64 + k] = silu_f(v); } \
        __syncthreads(); \
        const int ln = (F.lane < 48) ? F.lane : F.lane - 48, n = cchunk * 768 + F.wave * 96 + 2 * ln; \
        const float* wp = mod_w + ((size_t)(L) * DM + k0) * NMOD + n; \
        f32x2 a[9]; \
        _Pragma("unroll") for (int r = 0; r < 9; ++r) a[r] = (f32x2){0.f, 0.f}; \
        _Pragma("unroll 2") for (int k = 0; k < (KR); k += 4) { \
            const f32x2 wa = *(const f32x2*)(wp + (size_t)k * NMOD), wb = *(const f32x2*)(wp + (size_t)(k + 1) * NMOD), wc2 = *(const f32x2*)(wp + (size_t)(k + 2) * NMOD), wd = *(const f32x2*)(wp + (size_t)(k + 3) * NMOD); \
            _Pragma("unroll") for (int r = 0; r < 9; ++r) { const f32x4 s4 = *(const LAS f32x4*)(sl + r * 64 + k); a[r] = a[r] + wa * s4[0] + wb * s4[1] + wc2 * s4[2] + wd * s4[3]; } } \
        if (F.lane < 48) { \
            const f32x2 bias = (kchunk == 0) ? *(const f32x2*)(mod_b + (L) * NMOD + n) : (f32x2){0.f, 0.f}; \
            _Pragma("unroll") for (int r = 0; r < 9; ++r) { float* d = MOD + ((size_t)(L) * 9 + r) * NMOD + n; atomicAdd(d, a[r].x + bias.x); atomicAdd(d + 1, a[r].y + bias.y); } } \
        __syncthreads(); } while (0)
#define PREP_TRANSPOSE(L, wi, nw) do { \
        LAS float* scr = (LAS float*)(ring + F.wave * 16384); \
        constexpr int I_IN = 16 * (NIN / 32), I_OUT = 16 * (DM / 32), I_QKV = 16 * (NQKV / 32), I_O = 16 * (DM / 32), I_UP = 16 * (NUP / 32), I_DN = (DFF / 64) * (DM / 32); \
        constexpr int NITEMS = ((L) == 0 ? I_IN + I_OUT : I_QKV + I_O) + I_UP + I_DN; \
        const float* const w_a = KIN((L) == 0 ? 12 : 15); const float* const w_b = KIN((L) == 0 ? 14 : 18); const float* const ffn_w_up = KIN(19); const float* const ffn_w_down = KIN(21); \
        auto item_of = [&](int it) -> TrItem { \
            int r = it; constexpr int NA = (L) == 0 ? NIN : NQKV, IA = (L) == 0 ? I_IN : I_QKV, IB = (L) == 0 ? I_OUT : I_O; \
            if (r < IA) { const int nb = NA / 32; return TrItem{w_a, (L) == 0 ? Win_t : Wqkv_t, NA, DM, (r % nb) * 32, (r / nb) * 64, (r % nb) * 32}; } r -= IA; \
            if (r < IB) { const int nb = DM / 32; return TrItem{w_b, (L) == 0 ? Wout_t : Wo_t, DM, DM, (r % nb) * 32, (r / nb) * 64, (r % nb) * 32}; } r -= IB; \
            if (r < I_UP) { const int nb = NUP / 32, n0 = (r % nb) * 32, k0 = (r / nb) * 64; \
                const int bj = n0 / DFF, f = n0 % DFF, dest = (f / 128) * 256 + bj * 128 + (f % 128);     \
                return TrItem{ffn_w_up + (size_t)(L) * DM * NUP, Wup_t + (size_t)(L) * NUP * DM, NUP, DM, dest, k0, n0}; } r -= I_UP; \
            { const int nb = DM / 32; \
                return TrItem{ffn_w_down + (size_t)(L) * DFF * DM, Wdn_t + (size_t)(L) * DM * DFF, DM, DFF, (r % nb) * 32, (r / nb) * 64, (r % nb) * 32}; } \
        }; \
        if ((wi) < NITEMS) { \
            f32x4 va[8], vb[8]; TrItem ta = item_of(wi), tb = ta; tr_load(ta, va, F.lane); \
            for (int it = (wi); it < NITEMS; it += 2 * (nw)) { \
                const bool hb = it + (nw) < NITEMS; if (hb) { tb = item_of(it + (nw)); tr_load(tb, vb, F.lane); } \
                tr_finish(ta, va, scr, F.lane); \
                if (!hb) break; \
                const bool ha = it + 2 * (nw) < NITEMS; if (ha) { ta = item_of(it + 2 * (nw)); tr_load(ta, va, F.lane); } \
                tr_finish(tb, vb, scr, F.lane); \
                if (!ha) break; \
            } } } while (0)

    if (IN(0)) { PH_BEGIN();
        for (int it = F.vcu; it < 256; it += F.G) PREP_GEMV(0, 32, it);
        if (F.vcu == F.G - 1) {
            for (int e = F.tid; e < 64 * 32; e += 512) { const int pos = e >> 5, i = e & 31;
                double inv = 1.0; for (int q = 0; q < i; ++q) inv *= 0.74989420933245582730;
                double s, c; sincos_d((double)pos * inv, s, c);
                ROPE[2 * e] = (float)c; ROPE[2 * e + 1] = (float)s; }
        }
        PREP_TRANSPOSE(0, gw, NGW);
        if (MK_N_LAUNCHES != 1 || F.G != 256) {
            for (int it = F.vcu; it < 128; it += F.G) PREP_GEMV(1, 64, it);
            PREP_TRANSPOSE(1, gw, NGW);
        }
    }
    SEAM(0);
    if (IN(1)) { PH_BEGIN(); row_pass<0, true>(F, KIN(0), KIN(1), nullptr, nullptr, nullptr, XN, nullptr, nullptr, KIN(8), MOD + 0 * DM, MOD + 1 * DM); }
    SEAM(1);
    if (IN(2)) { PH_BEGIN(); pg8::Gemm g{XN, Win_t, T_ALL, NIN, DM, DM, DM}; pg8::StaticOrder S; S.init(T_ALL, NIN, F.G, (int)blockIdx.x, true); pg8::EpiBf16 E{CV, NIN};
        pg8::gemm_phase<pg8::EpiBf16>(ring, xbuf, g, S, E, F.tid); }
    SEAM(2);
    if (IN(3)) { PH_BEGIN();
        const float* const conv_k = KIN(13);
        for (int it = gw; it < (T_ALL / 8) * 2; it += NGW) {
            const int half = it & 1, t0 = (it >> 1) * 8, cb = half * 512 + 8 * F.lane;
            const int p0 = (t0 < T_CTX) ? (t0 & (SEQ_C - 1)) : ((t0 - T_CTX) & (SEQ_L - 1)), L = (t0 < T_CTX) ? SEQ_C : SEQ_L;
            float k0[8], k1[8], k2[8];
            { const f32x4 a = *(const f32x4*)(conv_k + cb), b = *(const f32x4*)(conv_k + cb + 4), c = *(const f32x4*)(conv_k + DM + cb), d = *(const f32x4*)(conv_k + DM + cb + 4),
                  e = *(const f32x4*)(conv_k + 2 * DM + cb), f = *(const f32x4*)(conv_k + 2 * DM + cb + 4);
#pragma unroll
              for (int j = 0; j < 4; ++j) { k0[j] = a[j]; k0[4 + j] = b[j]; k1[j] = c[j]; k1[4 + j] = d[j]; k2[j] = e[j]; k2[4 + j] = f[j]; } }
            float prev[8], cur[8], nxt[8];
#define PROD(dst, t) do { const u32x4 _c = *(const u32x4*)(CV + (size_t)(t) * NIN + DM + cb), _x = *(const u32x4*)(CV + (size_t)(t) * NIN + 2 * DM + cb); \
                _Pragma("unroll") for (int j = 0; j < 4; ++j) { dst[2 * j] = bflo(_c[j]) * bflo(_x[j]); dst[2 * j + 1] = bfhi(_c[j]) * bfhi(_x[j]); } } while (0)
#pragma unroll
            for (int j = 0; j < 8; ++j) prev[j] = 0.f;
            if (p0 > 0) PROD(prev, t0 - 1);
            PROD(cur, t0);
#pragma unroll
            for (int r = 0; r < 8; ++r) {
#pragma unroll
                for (int j = 0; j < 8; ++j) nxt[j] = 0.f;
                if (p0 + r + 1 < L) PROD(nxt, t0 + r + 1);
                bf16_t* bp = CV + (size_t)(t0 + r) * NIN + cb;
                const u32x4 bv = *(const u32x4*)bp; u32x4 o;
#pragma unroll
                for (int j = 0; j < 4; ++j) {
                    const float z0 = bflo(bv[j]) * fmaf(k2[2 * j], nxt[2 * j], fmaf(k1[2 * j], cur[2 * j], k0[2 * j] * prev[2 * j]));
                    const float z1 = bfhi(bv[j]) * fmaf(k2[2 * j + 1], nxt[2 * j + 1], fmaf(k1[2 * j + 1], cur[2 * j + 1], k0[2 * j + 1] * prev[2 * j + 1]));
                    o[j] = pk2(z0, z1); }
                *(u32x4*)bp = o;
#pragma unroll
                for (int j = 0; j < 8; ++j) { prev[j] = cur[j]; cur[j] = nxt[j]; }
            }
#undef PROD
        }
    }
    SEAM(3);
    if (IN(4)) { PH_BEGIN(); pg8::Gemm g{CV, Wout_t, T_ALL, DM, DM, NIN, DM}; pg8::StaticOrder S; S.init(T_ALL, DM, F.G, (int)blockIdx.x, true); pg8::EpiBf16 E{XN, DM};
        pg8::gemm_phase<pg8::EpiBf16>(ring, xbuf, g, S, E, F.tid); }
    SEAM(4);
    if (IN(5)) { PH_BEGIN(); row_pass<1, true>(F, KIN(0), KIN(1), HB, nullptr, XN, XN, KIN(9), MOD + 2 * DM, KIN(10), MOD + 3 * DM, MOD + 4 * DM); }
    SEAM(5);
#define FFN_UP(l) do { pg8::Gemm g{XN, Wup_t + (size_t)(l) * NUP * DM, T_ALL, NUP, DM, DM, DM}; pg8::StaticOrder S; S.init(T_ALL, NUP, F.G, (int)blockIdx.x); \
        pg8::EpiFfn E{A2, KIN(20) + (size_t)(l) * 3 * NUP, RAWB}; pg8::gemm_phase<pg8::EpiFfn>(ring, xbuf, g, S, E, F.tid); \
        if ((l) == 0 && MK_N_LAUNCHES == 1 && F.G == 256) {     \
            const int ii = (int)blockIdx.x - 64; \
            if (ii >= 0) { PH_BEGIN(); __syncthreads(); if (ii < 128) PREP_GEMV(1, 64, ii); PREP_TRANSPOSE(1, ii * 8 + F.wave, 192 * 8); } } } while (0)
#define FFN_FIX_ROW(cw, lt, sel) do { \
        const float* rm = RAWB + (size_t)((lt) * 4 + ((sel) ? 3 : 2)) * NUP; const float* rc = RAWB + (size_t)((sel) ? ((lt) + 1) * 4 + 0 : (lt) * 4 + 3) * NUP; const float* rp = RAWB + (size_t)(((lt) + 1) * 4 + ((sel) ? 1 : 0)) * NUP; \
        const int row = T_CTX + 256 * ((lt) + (sel)) + ((sel) ? 0 : 255); \
        for (int f = 4 * F.tid; f < DFF; f += 2048) { float a[4]; \
            const f32x4 g0 = *(const f32x4*)(rm + f), g1 = *(const f32x4*)(rc + f), g2 = *(const f32x4*)(rp + f), u0 = *(const f32x4*)(rm + DFF + f), u1 = *(const f32x4*)(rc + DFF + f), u2 = *(const f32x4*)(rp + DFF + f); \
            const f32x4 wg0 = *(const f32x4*)((cw) + f), wg1 = *(const f32x4*)((cw) + NUP + f), wg2 = *(const f32x4*)((cw) + 2 * NUP + f), wu0 = *(const f32x4*)((cw) + DFF + f), wu1 = *(const f32x4*)((cw) + NUP + DFF + f), wu2 = *(const f32x4*)((cw) + 2 * NUP + DFF + f); \
            _Pragma("unroll") for (int j = 0; j < 4; ++j) { float gc = wg1[j] * g1[j]; gc = fmaf(g0[j], wg0[j], gc); gc = fmaf(g2[j], wg2[j], gc); float uc = wu1[j] * u1[j]; uc = fmaf(u0[j], wu0[j], uc); uc = fmaf(u2[j], wu2[j], uc); a[j] = silu_f(gc) * uc; } \
            u32x2 w; w.x = cvt_pk_bf16(a[0], a[1]); w.y = cvt_pk_bf16(a[2], a[3]); *(u32x2*)(A2 + (size_t)row * DFF + f) = w; } } while (0)
#define FFN_DOWN(l) do { pg8::Gemm g{A2, Wdn_t + (size_t)(l) * DM * DFF, T_ALL, DM, DFF, DFF, DFF}; pg8::StaticOrder S; S.init(T_ALL, DM, F.G, (int)blockIdx.x, true); pg8::EpiBf16 E{XN, DM}; \
        { const float* cw = KIN(20) + (size_t)(l) * 3 * NUP; pg8::Unit uu; \
          for (int i = 0; S.next(i, uu); ++i) if (uu.pm >= 32) { const int lt = uu.pm - 32, ti = lt & 7; \
              if (ti != 0 && uu.half != 1) FFN_FIX_ROW(cw, lt - 1, 1);        \
              if (ti != 7 && uu.half != 0) FFN_FIX_ROW(cw, lt, 0); }           \
          VM_WAIT(); __syncthreads(); } \
        pg8::gemm_phase<pg8::EpiBf16>(ring, xbuf, g, S, E, F.tid); } while (0)
    if (IN(6)) { PH_BEGIN(); FFN_UP(0); }
    SEAM(6);
    if (IN(8)) { PH_BEGIN(); FFN_DOWN(0); }
    SEAM(8);
    if (IN(9)) { PH_BEGIN(); row_pass<1, false>(F, nullptr, nullptr, HB, nullptr, XN, XN, KIN(11), MOD + 5 * DM, KIN(8) + DM, MOD + (size_t)9 * NMOD + 0 * DM, MOD + (size_t)9 * NMOD + 1 * DM); }
    SEAM(9);
    if (IN(10)) { PH_BEGIN(); pg8::Gemm g{XN, Wqkv_t, T_ALL, NQKV, DM, DM, DM}; pg8::StaticOrder S; S.init(T_ALL, NQKV, F.G, (int)blockIdx.x, true); pg8::EpiBf16 E{QKV, NQKV};
        pg8::gemm_phase<pg8::EpiBf16>(ring, xbuf, g, S, E, F.tid); }
    SEAM(10);
    if (IN(11)) { PH_BEGIN();
        const float* const cache_k = KIN(2); const float* const cache_v = KIN(3); const float* const q_gain = KIN(16); const float* const k_gain = KIN(17);
        for (size_t i = (size_t)gw * 64 + F.lane; i < (size_t)8 * PAST * KVW / 8; i += (size_t)NGW * 64) {
            const size_t e = i * 8; const int b = (int)(e / ((size_t)PAST * KVW)); const size_t w = e % ((size_t)PAST * KVW);
            const f32x4 k0 = *(const f32x4*)(cache_k + e), k1 = *(const f32x4*)(cache_k + e + 4), v0 = *(const f32x4*)(cache_v + e), v1 = *(const f32x4*)(cache_v + e + 4);
            u32x4 ko, vo; ko.x = pk2(k0[0], k0[1]); ko.y = pk2(k0[2], k0[3]); ko.z = pk2(k1[0], k1[1]); ko.w = pk2(k1[2], k1[3]);
            vo.x = pk2(v0[0], v0[1]); vo.y = pk2(v0[2], v0[3]); vo.z = pk2(v1[0], v1[1]); vo.w = pk2(v1[2], v1[3]);
            *(u32x4*)(KALL + (size_t)b * KV_LAT * KVW + w) = ko; *(u32x4*)(VALL + (size_t)b * KV_LAT * KVW + w) = vo;
        }
        const int cc = F.lane & 15;
        float qg[8], kg[8];
        { const f32x4 a = *(const f32x4*)(q_gain + 8 * cc), b = *(const f32x4*)(q_gain + 8 * cc + 4), c = *(const f32x4*)(k_gain + 8 * cc), d = *(const f32x4*)(k_gain + 8 * cc + 4);
#pragma unroll
          for (int j = 0; j < 4; ++j) { qg[j] = a[j]; qg[4 + j] = b[j]; kg[j] = c[j]; kg[4 + j] = d[j]; } }
        for (int t = gw; t < T_ALL; t += NGW) {
            const bool lat = t >= T_CTX; const int tl = t - T_CTX, bl = tl / SEQ_L, tt = tl % SEQ_L;
            float cs[8], sn[8];
            if (lat) { const int pos = (cc < 8) ? (tt >> 6) : (tt & 63); const float* rp = ROPE + ((size_t)pos * 32 + 8 * (cc & 3)) * 2;
                const f32x4 r0 = *(const f32x4*)rp, r1 = *(const f32x4*)(rp + 4), r2 = *(const f32x4*)(rp + 8), r3 = *(const f32x4*)(rp + 12);
                cs[0] = r0[0]; sn[0] = r0[1]; cs[1] = r0[2]; sn[1] = r0[3]; cs[2] = r1[0]; sn[2] = r1[1]; cs[3] = r1[2]; sn[3] = r1[3];
                cs[4] = r2[0]; sn[4] = r2[1]; cs[5] = r2[2]; sn[5] = r2[3]; cs[6] = r3[0]; sn[6] = r3[1]; cs[7] = r3[2]; sn[7] = r3[3]; }
            const float sgn = ((cc & 7) < 4) ? -1.f : 1.f;
#pragma unroll
            for (int k = 0; k < 3; ++k) {
                const int c = F.lane + 64 * k, head = c >> 4;
                const u32x4 raw = *(const u32x4*)(QKV + (size_t)t * NQKV + 8 * c);
                float x[8];
#pragma unroll
                for (int j = 0; j < 4; ++j) { x[2 * j] = bflo(raw[j]); x[2 * j + 1] = bfhi(raw[j]); }
                const bool isv = (k == 2) && (F.lane >= 32), isq = (k < 2);
                {
                    float s = 0.f;
#pragma unroll
                    for (int j = 0; j < 8; ++j) s = fmaf(x[j], x[j], s);
                    s += __shfl_xor(s, 1); s += __shfl_xor(s, 2); s += __shfl_xor(s, 4); s += __shfl_xor(s, 8);
                    const float rs = __builtin_amdgcn_rsqf(s * (1.0f / HD) + EPS);
#pragma unroll
                    for (int j = 0; j < 8; ++j) x[j] = isv ? x[j] : x[j] * rs * (isq ? qg[j] : kg[j]);
                }
                float y[8];
#pragma unroll
                for (int j = 0; j < 8; ++j) { const float p = __shfl_xor(x[j], 4); y[j] = (lat && !isv) ? fmaf(x[j], cs[j], sgn * p * sn[j]) : x[j]; }
                u32x4 o; o.x = pk2(y[0], y[1]); o.y = pk2(y[2], y[3]); o.z = pk2(y[4], y[5]); o.w = pk2(y[6], y[7]);
                if (isq) { *(u32x4*)(QB + (size_t)t * DM + 8 * c) = o; }
                else {
                    const int kvc = 8 * (c - 128 - (isv ? 32 : 0));
                    if (lat) { bf16_t* dst = (isv ? VALL : KALL) + ((size_t)bl * KV_LAT + PAST + tt) * KVW + kvc; *(u32x4*)dst = o; }
                    else { bf16_t* dst = (isv ? VC : KC) + (size_t)t * KVW + kvc; *(u32x4*)dst = o;
                        float* nd = (isv ? new_v : new_k) + (size_t)t * KVW + kvc;
                        *(f32x4*)nd = (f32x4){y[0], y[1], y[2], y[3]}; *(f32x4*)(nd + 4) = (f32x4){y[4], y[5], y[6], y[7]}; }
                }
            }
        }
    }
    SEAM(11);
    if (IN(12)) { PH_BEGIN();
        char* albs = (char*)lds_raw;
        const int xg = (int)blockIdx.x & 7, j = (int)blockIdx.x >> 3;
        const int n_lat = 512, n_all = 512 + 256;
        for (int it0 = 0; ; ++it0) {
            int it;
            if (F.G == 256) { if (it0 >= 3) break; it = (it0 < 2) ? ((2 * xg + it0) * 32 + j) : (512 + F.vcu); }
            else { it = (int)blockIdx.x + it0 * F.G; if (it >= n_all) break; }
            const bf16_t *qp, *kp, *vp; bf16_t* op; int seq;
            if (it < n_lat) { const int grp = it >> 5, jj = it & 31, b = grp >> 1, kvh = grp & 1, h = kvh * 4 + (jj >> 3), qb = jj & 7;
                const size_t qo = ((size_t)(T_CTX + b * SEQ_L + qb * 256)) * DM + h * HD, ko = (size_t)b * KV_LAT * KVW + kvh * HD;
                qp = QB + qo; op = OB + qo; kp = KALL + ko; vp = VALL + ko; seq = KV_LAT; }
            else { const int ic = it - n_lat, b = ic >> 3, h = ic & 7, kvh = h >> 2;
                const size_t qo = (size_t)(b * SEQ_C) * DM + h * HD, ko = (size_t)(b * SEQ_C) * KVW + kvh * HD;
                qp = QB + qo; op = OB + qo; kp = KC + ko; vp = VC + ko; seq = SEQ_C; }
            __syncthreads();
            att::attn_dense_body(qp, kp, vp, op, seq, albs, F.tid);
        }
        __syncthreads();
    }
    SEAM(12);
    if (IN(13)) { PH_BEGIN(); pg8::Gemm g{OB, Wo_t, T_ALL, DM, DM, DM, DM}; pg8::StaticOrder S; S.init(T_ALL, DM, F.G, (int)blockIdx.x, true); pg8::EpiBf16 E{XN, DM};
        pg8::gemm_phase<pg8::EpiBf16>(ring, xbuf, g, S, E, F.tid); }
    SEAM(13);
    if (IN(14)) { PH_BEGIN(); row_pass<1, false>(F, nullptr, nullptr, HB, nullptr, XN, XN, KIN(9) + DM, MOD + (size_t)9 * NMOD + 2 * DM, KIN(10) + DM, MOD + (size_t)9 * NMOD + 3 * DM, MOD + (size_t)9 * NMOD + 4 * DM); }
    SEAM(14);
    if (IN(15)) { PH_BEGIN(); FFN_UP(1); }
    SEAM(15);
    if (IN(17)) { PH_BEGIN(); FFN_DOWN(1); }
    SEAM(17);
    if (IN(18)) { PH_BEGIN(); row_pass<2, false>(F, nullptr, nullptr, HB, H, XN, nullptr, KIN(11) + DM, MOD + (size_t)9 * NMOD + 5 * DM, nullptr, nullptr, nullptr); }
    PROBE_END(18);
#undef IN
#undef SEAM
}

extern "C" void kernel_launch(void* const* d_in, const int* in_sizes, int n_in, void* d_out, int out_size, void* d_ws, size_t ws_size, hipStream_t stream) {
    static int grid = 0;
    if (grid == 0) {
        const long want_out = (long)T_ALL * DM + 2L * T_CTX * KVW;
        if (n_in != 22 || in_sizes[0] != T_CTX * DM || in_sizes[1] != T_LAT * DM || (long)out_size != want_out || ws_size < WS_END) {
            fprintf(stderr, "kernel_launch: shape mismatch (n_in %d out %d ws %zu)\n", n_in, out_size, ws_size); grid = -1; return; }
        int dev = 0, cus = 0;
        if (hipGetDevice(&dev) != hipSuccess || hipDeviceGetAttribute(&cus, hipDeviceAttributeMultiprocessorCount, dev) != hipSuccess) { grid = -1; return; }
        if (hipFuncSetAttribute((const void*)mega_fwd, hipFuncAttributeMaxDynamicSharedMemorySize, LDS_BYTES) != hipSuccess) { fprintf(stderr, "kernel_launch: hipFuncSetAttribute failed\n"); grid = -1; return; }
        int per_cu = 0;
        if (hipOccupancyMaxActiveBlocksPerMultiprocessor(&per_cu, (const void*)mega_fwd, 512, LDS_BYTES) != hipSuccess || per_cu < 1) fprintf(stderr, "kernel_launch: occupancy query says %d\n", per_cu);
        (void)hipGetLastError();
        grid = cus;
    }
    if (grid < 0) return;
    (void)hipMemsetAsync((char*)d_ws + WS_CTL, 0, CTL_ZERO_BYTES, stream);
    (void)hipMemsetAsync((char*)d_ws + WS_MOD, 0, (size_t)2 * 9 * NMOD * 4, stream);
    Args a{};
    for (int i = 0; i < 22; ++i) a.in[i] = (const float*)d_in[i];
    a.out = (float*)d_out; a.ws = (unsigned char*)d_ws;
#if MK_N_LAUNCHES == 1
    a.ph_lo = 0; a.ph_hi = N_PHASES;
    hipLaunchKernelGGL(mega_fwd, dim3(grid), dim3(512), LDS_BYTES, stream, a);
#else
    for (int p = 0; p < N_PHASES; ++p) { a.ph_lo = p; a.ph_hi = p + 1; hipLaunchKernelGGL(mega_fwd, dim3(grid), dim3(512), LDS_BYTES, stream, a); }
#endif
    const hipError_t le = hipPeekAtLastError();
    if (le != hipSuccess) fprintf(stderr, "kernel_launch: launch failed: %s\n", hipGetErrorName(le));
}
```
